# Optimizing an MI355X kernel written in HIP

```python
import jax
import jax.numpy as jnp
from jax import lax
import numpy as np

D_MODEL = 1024
BATCH = 4
SEQ = 4096
DEPTH = 4
DEC_BATCH = 16
DEC_SEQ = 2048
PAST_LEN = 128

HEAD_DIM = 64
N_HEADS = D_MODEL // HEAD_DIM
MIX_WIDTH = N_HEADS * HEAD_DIM
Q_PER_KV = 2
A_HEADS = N_HEADS // 4
B_HEADS = (3 * N_HEADS) // 8
C_HEADS = N_HEADS - A_HEADS - B_HEADS
A_KV = A_HEADS // Q_PER_KV
B_KV = B_HEADS // Q_PER_KV
C_KV = C_HEADS // Q_PER_KV
KV_HEADS = A_KV + B_KV + C_KV
QKV_WIDTH = (N_HEADS + 2 * KV_HEADS) * HEAD_DIM
FFN_DIM = ((-(-8 * D_MODEL // 3) + 255) // 256) * 256

GRID_W = 64
NA_MAX_ROWS = 8
NA_COLS = 16
DILATED_BRANCHES = ((128, 1), (512, 4), (2048, 16))
Q_BLOCK = 128
ROPE_THETA = 10000.0
RMS_EPS = 1e-6
NEG_INF = -1e30

kernel_name = 'hybrid_parallel_head_encoder'


def rms_norm(x, gain):
    xf = x.astype(jnp.float32)
    y = xf * lax.rsqrt(jnp.mean(xf * xf, axis=-1, keepdims=True) + RMS_EPS)
    return (y * gain.astype(jnp.float32)).astype(x.dtype)


def rope_tables(pos, dim):
    inv_freq = ROPE_THETA ** (-jnp.arange(0, dim, 2, dtype=jnp.float32) / dim)
    ang = pos[:, None] * inv_freq[None, :]
    ang = jnp.concatenate([ang, ang], axis=-1)
    return jnp.cos(ang), jnp.sin(ang)


def apply_rope(x, cos, sin):
    xf = x.astype(jnp.float32)
    half = xf.shape[-1] // 2
    rot = jnp.concatenate([-xf[..., half:], xf[..., :half]], axis=-1)
    return (xf * cos[None, :, None, :] + rot * sin[None, :, None, :]).astype(x.dtype)


def apply_axial_rope(x, cos_r, sin_r, cos_c, sin_c):
    half = x.shape[-1] // 2
    return jnp.concatenate([apply_rope(x[..., :half], cos_r, sin_r),
                            apply_rope(x[..., half:], cos_c, sin_c)], axis=-1)


def dense_block_attention(q, k, v):
    b, t, hq, d = q.shape
    hkv = k.shape[2]
    g = hq // hkv
    nb = t // Q_BLOCK
    scale = d ** -0.5
    qb = jnp.moveaxis(q.reshape(b, nb, Q_BLOCK, hkv, g, d), 1, 0)

    def block(qi):
        s = jnp.einsum('bqhgd,bkhd->bhgqk', qi, k, preferred_element_type=jnp.float32) * scale
        p = jax.nn.softmax(s, axis=-1).astype(v.dtype)
        return jnp.einsum('bhgqk,bkhd->bqhgd', p, v)

    out = lax.map(block, qb)
    return jnp.moveaxis(out, 0, 1).reshape(b, t, hq, d)


def gathered_block_attention(q, k, v, idx, bias):
    b, t, hq, d = q.shape
    hkv = k.shape[2]
    g = hq // hkv
    nb = t // Q_BLOCK
    n_keys = idx.shape[1]
    hb = bias.shape[0]
    bias_heads = (hkv, g) if hb == hq else (1, 1)
    scale = d ** -0.5
    qb = jnp.moveaxis(q.reshape(b, nb, Q_BLOCK, hkv, g, d), 1, 0)
    ib = idx.reshape(nb, Q_BLOCK, n_keys)
    bb = jnp.moveaxis(bias.reshape(hb, nb, Q_BLOCK, n_keys), 1, 0)

    def block(args):
        qi, ii, bi = args
        kg = k[:, ii]
        vg = v[:, ii]
        s = jnp.einsum('bqhgd,bqkhd->bhgqk', qi, kg, preferred_element_type=jnp.float32) * scale
        s = s + bi.reshape(bias_heads + (Q_BLOCK, n_keys))[None].astype(jnp.float32)
        lse = jax.nn.logsumexp(s, axis=-1)
        p = jnp.exp(s - lse[..., None]).astype(v.dtype)
        o = jnp.einsum('bhgqk,bqkhd->bqhgd', p, vg)
        return o, jnp.moveaxis(lse, 3, 1)

    out, lse = lax.map(block, (qb, ib, bb))
    out = jnp.moveaxis(out, 0, 1).reshape(b, t, hq, d)
    lse = jnp.moveaxis(lse, 0, 1).reshape(b, t, hq)
    return out, lse


def neighbourhood_pattern(t):
    rows = t // GRID_W
    kh = min(NA_MAX_ROWS, rows)
    pos = jnp.arange(t, dtype=jnp.int32)
    r, c = pos // GRID_W, pos % GRID_W
    r0 = jnp.clip(r - kh // 2, 0, rows - kh)
    c0 = jnp.clip(c - NA_COLS // 2, 0, GRID_W - NA_COLS)
    key_r = r0[:, None, None] + jnp.arange(kh, dtype=jnp.int32)[None, :, None]
    key_c = c0[:, None, None] + jnp.arange(NA_COLS, dtype=jnp.int32)[None, None, :]
    idx = (key_r * GRID_W + key_c).reshape(t, kh * NA_COLS)
    off_r = jnp.broadcast_to(key_r - r[:, None, None] + (NA_MAX_ROWS - 1), (t, kh, NA_COLS)).reshape(t, -1)
    off_c = jnp.broadcast_to(key_c - c[:, None, None] + (NA_COLS - 1), (t, kh, NA_COLS)).reshape(t, -1)
    return idx, off_r, off_c


def dilated_pattern(t, window, dilation):
    half = window // (2 * dilation)
    pos = jnp.arange(t, dtype=jnp.int32)
    keys = pos[:, None] + jnp.arange(-half, half + 1, dtype=jnp.int32)[None, :] * dilation
    valid = (keys >= 0) & (keys < t)
    bias = jnp.where(valid, 0.0, NEG_INF).astype(jnp.float32)[None]
    return jnp.clip(keys, 0, t - 1), bias


def encoder_trunk(x, norm_mix, w_in, q_gain, k_gain, rpb, out_gain, w_out, norm_ffn, w_gate_up, w_down):
    b, t, _ = x.shape
    pos = jnp.arange(t, dtype=jnp.int32)
    half_dim = HEAD_DIM // 2
    cos_r, sin_r = rope_tables((pos // GRID_W).astype(jnp.float32), half_dim)
    cos_c, sin_c = rope_tables((pos % GRID_W).astype(jnp.float32), half_dim)
    cos_1d, sin_1d = rope_tables(pos.astype(jnp.float32), HEAD_DIM)
    na_idx, na_dr, na_dc = neighbourhood_pattern(t)
    dil = [dilated_pattern(t, w, d) for (w, d) in DILATED_BRANCHES]
    a_w = A_HEADS * HEAD_DIM
    b_w = B_HEADS * HEAD_DIM
    k_off = MIX_WIDTH
    v_off = MIX_WIDTH + KV_HEADS * HEAD_DIM
    for l in range(DEPTH):
        h = rms_norm(x, norm_mix[l])
        proj = h @ w_in[l]
        q = proj[..., :k_off].reshape(b, t, N_HEADS, HEAD_DIM)
        k = proj[..., k_off:v_off].reshape(b, t, KV_HEADS, HEAD_DIM)
        v = proj[..., v_off:].reshape(b, t, KV_HEADS, HEAD_DIM)

        q_a = apply_axial_rope(rms_norm(q[:, :, :A_HEADS], q_gain[l, 0]), cos_r, sin_r, cos_c, sin_c)
        k_a = apply_axial_rope(rms_norm(k[:, :, :A_KV], k_gain[l, 0]), cos_r, sin_r, cos_c, sin_c)
        o_a = dense_block_attention(q_a, k_a, v[:, :, :A_KV])

        q_b = rms_norm(q[:, :, A_HEADS:A_HEADS + B_HEADS], q_gain[l, 1])
        k_b = rms_norm(k[:, :, A_KV:A_KV + B_KV], k_gain[l, 1])
        bias_b = rpb[l][:, na_dr, na_dc]
        o_b, _ = gathered_block_attention(q_b, k_b, v[:, :, A_KV:A_KV + B_KV], na_idx, bias_b)

        q_c = apply_rope(rms_norm(q[:, :, A_HEADS + B_HEADS:], q_gain[l, 2]), cos_1d, sin_1d)
        k_c = apply_rope(rms_norm(k[:, :, A_KV + B_KV:], k_gain[l, 2]), cos_1d, sin_1d)
        v_c = v[:, :, A_KV + B_KV:]
        branches = [gathered_block_attention(q_c, k_c, v_c, idx, bias) for (idx, bias) in dil]
        outs = jnp.stack([o for (o, _) in branches]).astype(jnp.float32)
        lses = jnp.stack([s for (_, s) in branches])
        wts = jax.nn.softmax(lses, axis=0)
        o_c = jnp.einsum('nbth,nbthd->bthd', wts, outs).astype(x.dtype)

        y = jnp.concatenate([
            rms_norm(o_a.reshape(b, t, a_w), out_gain[l, :a_w]),
            rms_norm(o_b.reshape(b, t, b_w), out_gain[l, a_w:a_w + b_w]),
            rms_norm(o_c.reshape(b, t, MIX_WIDTH - a_w - b_w), out_gain[l, a_w + b_w:]),
        ], axis=-1)
        x = x + y @ w_out[l]

        h = rms_norm(x, norm_ffn[l])
        gate, up = jnp.split(h @ w_gate_up[l], 2, axis=-1)
        x = x + (jax.nn.silu(gate) * up) @ w_down[l]
    return x


def setup_inputs(seed: int = 0) -> dict:
    key = jax.random.key(seed)
    ks = jax.random.split(key, 12)
    nrm = jax.random.normal
    return {
        'x_prompt': nrm(ks[0], (BATCH, SEQ, D_MODEL), jnp.float32),
        'x_sample': nrm(ks[1], (DEC_BATCH, DEC_SEQ, D_MODEL), jnp.float32),
        'norm_mix': 1.0 + 0.02 * nrm(ks[2], (DEPTH, D_MODEL), jnp.float32),
        'w_in': nrm(ks[3], (DEPTH, D_MODEL, QKV_WIDTH), jnp.float32) * D_MODEL ** -0.5,
        'q_gain': 1.0 + 0.02 * nrm(ks[4], (DEPTH, 3, HEAD_DIM), jnp.float32),
        'k_gain': 1.0 + 0.02 * nrm(ks[5], (DEPTH, 3, HEAD_DIM), jnp.float32),
        'rpb': 0.1 * nrm(ks[6], (DEPTH, B_HEADS, 2 * NA_MAX_ROWS - 1, 2 * NA_COLS - 1), jnp.float32),
        'out_gain': 1.0 + 0.02 * nrm(ks[7], (DEPTH, MIX_WIDTH), jnp.float32),
        'w_out': nrm(ks[8], (DEPTH, MIX_WIDTH, D_MODEL), jnp.float32) * MIX_WIDTH ** -0.5,
        'norm_ffn': 1.0 + 0.02 * nrm(ks[9], (DEPTH, D_MODEL), jnp.float32),
        'w_gate_up': nrm(ks[10], (DEPTH, D_MODEL, 2 * FFN_DIM), jnp.float32) * D_MODEL ** -0.5,
        'w_down': nrm(ks[11], (DEPTH, FFN_DIM, D_MODEL), jnp.float32) * FFN_DIM ** -0.5,
    }


def reference(x_prompt, x_sample, norm_mix, w_in, q_gain, k_gain, rpb, out_gain, w_out, norm_ffn, w_gate_up, w_down):
    y_prompt = encoder_trunk(x_prompt, norm_mix, w_in, q_gain, k_gain, rpb, out_gain, w_out, norm_ffn, w_gate_up, w_down)
    y_sample = encoder_trunk(x_sample, norm_mix, w_in, q_gain, k_gain, rpb, out_gain, w_out, norm_ffn, w_gate_up, w_down)
    return (y_prompt, y_sample)
```

```cpp
#include <hip/hip_runtime.h>
#include <cstdio>
#include <cstdint>
namespace pg8 {
#define PG8_LAS __attribute__((address_space(3)))
typedef unsigned short bf16_t;
typedef short bf16x8 __attribute__((ext_vector_type(8)));
typedef float f32x4 __attribute__((ext_vector_type(4)));
typedef unsigned u32x4 __attribute__((ext_vector_type(4)));
constexpr int BM = 256, BK = 64, HALF = 128, HTB = HALF * BK * 2  , STAGE_BYTES = 8 * HTB, NXCD = 8, WGM = 8;

__host__ __device__ __forceinline__ int lds_byte(int r, int c) { const int st = (r >> 4) * 2 + (c >> 5), rr = r & 15, cc = c & 31, ob = rr * 64 + cc * 2; return st * 1024 + (ob ^ (((ob >> 9) & 1) << 5)); }
__host__ __device__ __forceinline__ void stage_rc(int b, int& R, int& C) { const int st = b / 1024, sb = b % 1024, swz = sb ^ (((sb >> 9) & 1) << 5); R = (st >> 1) * 16 + swz / 64; C = (st & 1) * 32 + (swz % 64) / 2; }
__host__ __device__ __forceinline__ int perm32(int rho) { const int n = rho >> 4, i = rho & 15; return 8 * (i >> 2) + 4 * n + (i & 3); }

struct Unit { int pm, pn; };
struct Gemm { const bf16_t* A; const bf16_t* Bt; int M, N, K; };

struct StaticOrder {
    int nM, nN, nwg, G, c;
    __host__ __device__ void init(int M, int N, int G_, int c_) { nM = M / BM; nN = N / BM; nwg = nM * nN; G = G_; c = c_; }
    __host__ __device__ bool next(int i, Unit& u) const {
        const long L = (long)i * G + c; if (L >= nwg) return false;
        int wgid = (int)L; { const int q = nwg / NXCD, r = nwg % NXCD, xcd = wgid % NXCD, off = wgid / NXCD; wgid = (xcd < r ? xcd * (q + 1) : r * (q + 1) + (xcd - r) * q) + off; }
        const int nig = WGM * nN, gid = wgid / nig, fm = gid * WGM, gsz = (nM - fm) < WGM ? (nM - fm) : WGM;
        u.pm = fm + ((wgid % nig) % gsz); u.pn = (wgid % nig) / gsz; return true;
    }
    __device__ __forceinline__ void a_ready(const Unit&) const {}
    __device__ __forceinline__ void done(const Unit&) const {}
};

__device__ __forceinline__ unsigned cvt_pk_bf16(float lo, float hi) { unsigned r; asm volatile("v_cvt_pk_bf16_f32 %0, %1, %2" : "=v"(r) : "v"(lo), "v"(hi)); return r; }
typedef float f32x2 __attribute__((ext_vector_type(2)));
constexpr float RMS_EPS = 1e-6f;
typedef unsigned long long u64;
__device__ __forceinline__ void ssq_add(u64* p, float v) { atomicAdd(p, (u64)(v * 1073741824.0f)); }
__device__ __forceinline__ float ssq_get(const u64* p) { return (float)(*p) * (1.0f / 1073741824.0f); }
constexpr float QSCALE = 0.125f * 1.4426950408889634f;
__device__ __forceinline__ int seq_pos(int row) { return row < 16384 ? (row & 4095) : (row & 2047); }
__device__ __forceinline__ u32x4 pack8(const f32x4 a, const f32x4 b) { u32x4 w; w.x = cvt_pk_bf16(a[0], a[1]); w.y = cvt_pk_bf16(a[2], a[3]); w.z = cvt_pk_bf16(b[0], b[1]); w.w = cvt_pk_bf16(b[2], b[3]); return w; }

struct EpiQKV {
    static constexpr bool PERM = true, AFTER_DRAIN = false, KHOOK = false, SSQ_LDS = true;
    bf16_t* QKV; bf16_t* KVC; const u64* ssq; const float* tab; int layer; PG8_LAS unsigned char* stab;
    __device__ __forceinline__ void prefetch(const Unit& u, int ui, int wid, int lane) const {
        __builtin_amdgcn_global_load_lds((const unsigned*)(ssq + (size_t)u.pm * BM) + wid * 64 + lane, (PG8_LAS unsigned*)(stab + (ui & 1) * 2048 + wid * 256), 4, 0, 0); }
    __device__ __forceinline__ void epi(const f32x4 (&acc)[2][2][4][2], const Unit& u, int wr, int wc, int fr, int fq, int ui) const {
        const int hd = u.pn * 4 + wc;
        int kind, mixer;
        if (hd < 16) { kind = 0; mixer = hd < 4 ? 0 : (hd < 10 ? 1 : 2); }
        else if (hd < 24) { kind = 1; const int kh = hd - 16; mixer = kh < 2 ? 0 : (kh < 5 ? 1 : 2); }
        else { kind = 2; mixer = 1; }
        const bool typeA = (kind != 2) && (mixer == 0);
        const int db0 = typeA ? (32 * (fq >> 1) + 8 * (fq & 1)) : 8 * fq;
        const int dstep = typeA ? 16 : 32;
        const float* cos1 = tab; const float* sin1 = tab + 131072; const float* cosax = tab + 262144; const float* sinax = tab + 263168;
        const float* gp = tab + 264192 + layer * 384 + (kind == 1 ? 192 : 0) + mixer * 64 + db0;
        const float qs = (kind == 0) ? QSCALE : 1.f;
        const bool rope = (kind != 2) && (mixer != 1);
        const int row0 = u.pm * BM + wr * 64 + fr;
        float rr[8];
#pragma unroll
        for (int i = 0; i < 8; ++i) rr[i] = (float)(*(const PG8_LAS u64*)(stab + (ui & 1) * 2048 + (wr * 64 + fr + (i >> 2) * HALF + (i & 3) * 16) * 8)) * (1.0f / 1073741824.0f);
        f32x4 gn[2][2];
#pragma unroll
        for (int bj = 0; bj < 2; ++bj)
#pragma unroll
            for (int n = 0; n < 2; ++n) gn[bj][n] = (kind != 2) ? *(const f32x4*)(gp + bj * dstep + 4 * n) : (f32x4){1.f, 1.f, 1.f, 1.f};
        f32x4 cn[2], sn[2];
#define QKV_TAB(i_) do { if (rope) { const int t_ = seq_pos(row0 + ((i_) >> 2) * HALF + ((i_) & 3) * 16); const float* cp_; const float* sp_; \
            if (mixer == 0) { const int pos_ = (fq >> 1) ? (t_ & 63) : (t_ >> 6); cp_ = cosax + pos_ * 16 + 8 * (fq & 1); sp_ = sinax + pos_ * 16 + 8 * (fq & 1); } \
            else { cp_ = cos1 + t_ * 32 + 8 * fq; sp_ = sin1 + t_ * 32 + 8 * fq; } \
            cn[0] = *(const f32x4*)cp_; cn[1] = *(const f32x4*)(cp_ + 4); sn[0] = *(const f32x4*)sp_; sn[1] = *(const f32x4*)(sp_ + 4); } } while (0)
        QKV_TAB(0);
#pragma unroll
        for (int i = 0; i < 8; ++i) {
            const int ai = i >> 2, m = i & 3;
            const int row = row0 + ai * HALF + m * 16;
            const f32x4 c0 = cn[0], c1 = cn[1], s0 = sn[0], s1 = sn[1];
            if (i + 1 < 8) QKV_TAB(i + 1);
            const float r = rsqrtf(rr[i] * (1.0f / 1024.0f) + RMS_EPS);
            f32x4 v[2][2];
#pragma unroll
            for (int bj = 0; bj < 2; ++bj)
#pragma unroll
                for (int n = 0; n < 2; ++n) v[bj][n] = acc[ai][bj][m][n] * r;
            if (kind != 2) {
                float ss = 0.f;
#pragma unroll
                for (int bj = 0; bj < 2; ++bj)
#pragma unroll
                    for (int n = 0; n < 2; ++n) { const f32x4 x = v[bj][n]; ss += (x[0] * x[0] + x[1] * x[1]) + (x[2] * x[2] + x[3] * x[3]); }
                ss += __shfl_xor(ss, 16); ss += __shfl_xor(ss, 32);
                const float rn = rsqrtf(ss * (1.0f / 64.0f) + RMS_EPS);
#pragma unroll
                for (int bj = 0; bj < 2; ++bj)
#pragma unroll
                    for (int n = 0; n < 2; ++n) v[bj][n] = v[bj][n] * rn * gn[bj][n];
                if (rope) {
                    { const f32x4 x1 = v[0][0], x2 = v[1][0]; v[0][0] = x1 * c0 - x2 * s0; v[1][0] = x2 * c0 + x1 * s0; }
                    { const f32x4 x1 = v[0][1], x2 = v[1][1]; v[0][1] = x1 * c1 - x2 * s1; v[1][1] = x2 * c1 + x1 * s1; }
                }
#pragma unroll
                for (int bj = 0; bj < 2; ++bj)
#pragma unroll
                    for (int n = 0; n < 2; ++n) v[bj][n] = v[bj][n] * qs;
            }
            bf16_t* rowp = QKV + (size_t)row * 2048 + hd * 64 + db0;
            if (hd >= 18 && hd < 24) rowp = KVC + ((size_t)(hd - 18) * 49152 + row) * 128 + db0;
            else if (hd >= 26) rowp = KVC + ((size_t)(hd - 26) * 49152 + row) * 128 + 64 + db0;
#pragma unroll
            for (int bj = 0; bj < 2; ++bj) *(u32x4*)(rowp + bj * dstep) = pack8(v[bj][0], v[bj][1]);
            asm volatile("" ::: "memory");
        }
#undef QKV_TAB
    }
};

struct EpiGU {
    static constexpr bool PERM = true, AFTER_DRAIN = false, KHOOK = false, SSQ_LDS = true;
    bf16_t* H; const u64* ssq; PG8_LAS unsigned char* stab;
    __device__ __forceinline__ void prefetch(const Unit& u, int ui, int wid, int lane) const {
        __builtin_amdgcn_global_load_lds((const unsigned*)(ssq + (size_t)u.pm * BM) + wid * 64 + lane, (PG8_LAS unsigned*)(stab + (ui & 1) * 2048 + wid * 256), 4, 0, 0); }
    __device__ __forceinline__ void epi(const f32x4 (&acc)[2][2][4][2], const Unit& u, int wr, int wc, int fr, int fq, int ui) const {
        const int col0 = u.pn * HALF + wc * 32 + 8 * fq;
#pragma unroll
        for (int ai = 0; ai < 2; ++ai)
#pragma unroll
            for (int m = 0; m < 4; ++m) {
                const int row = u.pm * BM + ai * HALF + wr * 64 + m * 16 + fr;
                const float r = rsqrtf((float)(*(const PG8_LAS u64*)(stab + (ui & 1) * 2048 + (ai * HALF + wr * 64 + m * 16 + fr) * 8)) * (1.0f / 1073741824.0f) * (1.0f / 1024.0f) + RMS_EPS);
                f32x4 h[2];
#pragma unroll
                for (int n = 0; n < 2; ++n) {
                    const f32x4 g = acc[ai][0][m][n] * r, uu = acc[ai][1][m][n] * r;
#pragma unroll
                    for (int e = 0; e < 4; ++e) { const float sg = __builtin_amdgcn_rcpf(1.0f + __builtin_amdgcn_exp2f(-1.4426950408889634f * g[e])); h[n][e] = g[e] * sg * uu[e]; }
                }
                __builtin_nontemporal_store(pack8(h[0], h[1]), (u32x4*)(H + (size_t)row * 2816 + col0));
            }
    }
};

template <bool LAST> struct EpiRes2 {
    static constexpr bool PERM = true, AFTER_DRAIN = false, KHOOK = false, SSQ_LDS = false;
    bf16_t* XB; float* out; u64* ssq_next;
    __device__ __forceinline__ void operator()(const f32x4 (&acc)[2][2][4][2], const Unit& u, int wr, int wc, int fr, int fq) const {
        const int col0 = u.pn * BM + wc * 32 + 8 * fq;
        const int row0 = u.pm * BM + wr * 64 + fr;
        u32x4 w[8][2];
#pragma unroll
        for (int i = 0; i < 8; ++i)
#pragma unroll
            for (int bj = 0; bj < 2; ++bj) w[i][bj] = *(const u32x4*)(XB + (size_t)(row0 + (i >> 2) * HALF + (i & 3) * 16) * 1024 + col0 + bj * HALF);
#pragma unroll
        for (int i = 0; i < 8; ++i) {
            const int ai = i >> 2, m = i & 3;
            const int row = row0 + ai * HALF + m * 16;
            float ss = 0.f;
#pragma unroll
            for (int bj = 0; bj < 2; ++bj) {
                f32x4 x[2];
#pragma unroll
                for (int n = 0; n < 2; ++n) { const unsigned lo = w[i][bj][2 * n], hi = w[i][bj][2 * n + 1];
                    const f32x4 bs = (f32x4){__uint_as_float(lo << 16), __uint_as_float(lo & 0xffff0000u), __uint_as_float(hi << 16), __uint_as_float(hi & 0xffff0000u)};
                    x[n] = bs + acc[ai][bj][m][n]; ss += (x[n][0] * x[n][0] + x[n][1] * x[n][1]) + (x[n][2] * x[n][2] + x[n][3] * x[n][3]); }
                if (LAST) { float* op = out + (size_t)row * 1024 + col0 + bj * HALF; *(f32x4*)op = x[0]; *(f32x4*)(op + 4) = x[1]; }
                else *(u32x4*)(XB + (size_t)row * 1024 + col0 + bj * HALF) = pack8(x[0], x[1]);
            }
            if (!LAST) { ss += __shfl_xor(ss, 16); ss += __shfl_xor(ss, 32); if (fq == 0) ssq_add(ssq_next + row, ss); }
        }
    }
};
template <class Epi, class Sched, bool ALIGN_EPI = false, bool SP2 = false>
__device__ __forceinline__ void gemm_phase(PG8_LAS unsigned char* lds, const Gemm g, const Sched& S, const Epi& E) {
    int tid_ = threadIdx.x; asm volatile("" : "+v"(tid_));
    const int tid = tid_, wid = __builtin_amdgcn_readfirstlane(tid >> 6), lane = tid & 63, wr = wid >> 2, wc = wid & 3, fr = lane & 15, fq = lane >> 4;
    const int K = g.K, nt = K / BK;
    unsigned voffA[2], voffB[2];
#pragma unroll
    for (int i = 0; i < 2; ++i) { int R, C; stage_rc(tid * 16 + i * 8192, R, C); const int Rb = Epi::PERM ? ((R & ~31) + perm32(R & 31)) : R;
        voffA[i] = (unsigned)(R * K + C) * 2u; voffB[i] = (unsigned)(Rb * K + C) * 2u; }
    const size_t kstep = (size_t)(BK * 2);
    const size_t hstep = (size_t)HALF * K * 2;
    const size_t tstep = 2 * hstep;
    const unsigned ldsw = (unsigned)wid * 1024u;
    const int aoff = lds_byte(wr * 64 + fr, fq * 8), boff = lds_byte(wc * 32 + fr, fq * 8);
#define PG8_SA(b, h) (((b) * 2 + (h)) * HTB)
#define PG8_SB(b, h) ((4 + (b) * 2 + (h)) * HTB)
#define PG8_STAGE(bufoff, gbase, voff) do { _Pragma("unroll") for (int _i = 0; _i < 2; ++_i) \
        __builtin_amdgcn_global_load_lds((const unsigned*)((const char*)(gbase) + (voff)[_i]), (PG8_LAS unsigned*)(lds + (bufoff) + ldsw + _i * 8192), 16, 0, 0); } while (0)
#define PG8_LDA(dst, b, h) do { _Pragma("unroll") for (int m = 0; m < 4; ++m) _Pragma("unroll") for (int k = 0; k < 2; ++k) dst[m][k] = *(const PG8_LAS bf16x8*)(lds + PG8_SA(b, h) + aoff + m * 2048 + k * 1024); } while (0)
#define PG8_LDB(dst, b, h) do { _Pragma("unroll") for (int n = 0; n < 2; ++n) _Pragma("unroll") for (int k = 0; k < 2; ++k) dst[n][k] = *(const PG8_LAS bf16x8*)(lds + PG8_SB(b, h) + boff + n * 2048 + k * 1024); } while (0)
#define PG8_MMA(ai, bj, At, Bt) do { __builtin_amdgcn_s_setprio(1); _Pragma("unroll") for (int m = 0; m < 4; ++m) _Pragma("unroll") for (int n = 0; n < 2; ++n) _Pragma("unroll") for (int k = 0; k < 2; ++k) \
        acc[ai][bj][m][n] = __builtin_amdgcn_mfma_f32_16x16x32_bf16(Bt[n][k], At[m][k], acc[ai][bj][m][n], 0, 0, 0); __builtin_amdgcn_s_setprio(0); } while (0)
#define PG8_WAIT_V(n) asm volatile("s_waitcnt vmcnt(" #n ")" ::: "memory")
#define PG8_WAIT_L(n) asm volatile("s_waitcnt lgkmcnt(" #n ")" ::: "memory")
#define PG8_BAR __builtin_amdgcn_s_barrier()
#define PG8_SCHED __builtin_amdgcn_sched_barrier(0)
    Unit cur, nxt; int ui = 0;
    if (!S.next(0, cur)) return;
    f32x4 acc[2][2][4][2];
#pragma unroll
    for (int a = 0; a < 2; ++a)
#pragma unroll
        for (int b = 0; b < 2; ++b)
#pragma unroll
            for (int m = 0; m < 4; ++m)
#pragma unroll
                for (int n = 0; n < 2; ++n) acc[a][b][m][n] = (f32x4){0.f, 0.f, 0.f, 0.f};
    bf16x8 At[4][2], B0[2][2], B1[2][2];
    const char* cA = (const char*)g.A + (size_t)cur.pm * tstep; const char* cB = (const char*)g.Bt + (size_t)cur.pn * tstep;
    S.a_ready(cur);
    if constexpr (SP2) {
        PG8_STAGE(PG8_SB(0, 0), cB, voffB); PG8_STAGE(PG8_SB(0, 1), cB + hstep, voffB); PG8_STAGE(PG8_SA(0, 0), cA, voffA); PG8_STAGE(PG8_SA(0, 1), cA + hstep, voffA);
        if (wr == 1) PG8_BAR;
        PG8_WAIT_V(2); PG8_BAR;
        PG8_STAGE(PG8_SB(1, 0), cB + kstep, voffB); PG8_STAGE(PG8_SA(1, 0), cA + kstep, voffA); PG8_STAGE(PG8_SB(1, 1), cB + hstep + kstep, voffB);
        PG8_WAIT_V(6); PG8_BAR;
    } else {
        PG8_STAGE(PG8_SB(0, 0), cB, voffB); PG8_STAGE(PG8_SA(0, 0), cA, voffA); PG8_STAGE(PG8_SB(0, 1), cB + hstep, voffB); PG8_STAGE(PG8_SA(0, 1), cA + hstep, voffA);
        if (wr == 1) PG8_BAR;
        PG8_WAIT_V(4); PG8_BAR;
        PG8_STAGE(PG8_SB(1, 0), cB + kstep, voffB); PG8_STAGE(PG8_SA(1, 0), cA + kstep, voffA); PG8_STAGE(PG8_SB(1, 1), cB + hstep + kstep, voffB);
        PG8_WAIT_V(6); PG8_BAR;
    }
    for (;;) {
        const bool has_next = S.next(ui + 1, nxt);
        if constexpr (Epi::SSQ_LDS) E.prefetch(cur, ui, wid, lane);
        const char* nA = has_next ? (const char*)g.A + (size_t)nxt.pm * tstep : cA; const char* nB = has_next ? (const char*)g.Bt + (size_t)nxt.pn * tstep : cB;
        for (int t = 0; t < nt; t += 2) {
            const bool last = (t == nt - 2);
            if constexpr (Epi::KHOOK) { if (t == 4 || t == 10) { PG8_SCHED; asm volatile("" ::: "memory"); E.khook(acc, cur, wr, fr, t == 4 ? 0 : 1); asm volatile("" ::: "memory"); PG8_SCHED; } }
            const char* a1 = cA + (size_t)(t + 1) * kstep;
            const char* a2 = last ? nA : cA + (size_t)(t + 2) * kstep; const char* b2 = last ? nB : cB + (size_t)(t + 2) * kstep;
            const char* a3 = a2 + kstep; const char* b3 = b2 + kstep;
            if (last && has_next) S.a_ready(nxt);
            if constexpr (SP2) {
            PG8_LDB(B0, 0, 0); PG8_LDB(B1, 0, 1); PG8_SCHED; PG8_LDA(At, 0, 0); PG8_STAGE(PG8_SA(1, 1), a1 + hstep, voffA);
            PG8_WAIT_V(8); PG8_WAIT_L(0); PG8_BAR; PG8_MMA(0, 0, At, B0); PG8_MMA(0, 1, At, B1); PG8_BAR; PG8_SCHED;
            PG8_LDA(At, 0, 1); PG8_STAGE(PG8_SB(0, 0), b2, voffB); PG8_STAGE(PG8_SB(0, 1), b2 + hstep, voffB); PG8_STAGE(PG8_SA(0, 0), a2, voffA);
            PG8_WAIT_V(8); PG8_WAIT_L(0); PG8_BAR; PG8_MMA(1, 0, At, B0); PG8_MMA(1, 1, At, B1); PG8_BAR; PG8_SCHED;
            PG8_LDB(B0, 1, 0); PG8_LDB(B1, 1, 1); PG8_SCHED; PG8_LDA(At, 1, 0); PG8_STAGE(PG8_SA(0, 1), a2 + hstep, voffA);
            PG8_WAIT_V(8); PG8_WAIT_L(0); PG8_BAR; PG8_MMA(0, 0, At, B0); PG8_MMA(0, 1, At, B1); PG8_BAR; PG8_SCHED;
            PG8_LDA(At, 1, 1); PG8_STAGE(PG8_SB(1, 0), b3, voffB); PG8_STAGE(PG8_SB(1, 1), b3 + hstep, voffB); PG8_STAGE(PG8_SA(1, 0), a3, voffA);
            PG8_WAIT_V(8); PG8_WAIT_L(0); PG8_BAR; PG8_MMA(1, 0, At, B0); PG8_MMA(1, 1, At, B1); PG8_BAR; PG8_SCHED;
            } else {
            PG8_LDB(B0, 0, 0); PG8_SCHED; PG8_LDA(At, 0, 0); PG8_STAGE(PG8_SA(1, 1), a1 + hstep, voffA);
            PG8_WAIT_L(8); PG8_BAR; PG8_WAIT_L(0); PG8_MMA(0, 0, At, B0); PG8_BAR; PG8_SCHED;
            PG8_LDB(B1, 0, 1); PG8_STAGE(PG8_SB(0, 0), b2, voffB);
            PG8_BAR; PG8_WAIT_L(0); PG8_MMA(0, 1, At, B1); PG8_BAR;
            PG8_LDA(At, 0, 1); PG8_STAGE(PG8_SA(0, 0), a2, voffA);
            PG8_BAR; PG8_WAIT_L(0); PG8_MMA(1, 0, At, B0); PG8_BAR; PG8_SCHED;
            PG8_STAGE(PG8_SB(0, 1), b2 + hstep, voffB);
            PG8_WAIT_V(6); PG8_BAR; PG8_MMA(1, 1, At, B1); PG8_BAR;
            PG8_LDB(B0, 1, 0); PG8_SCHED; PG8_LDA(At, 1, 0); PG8_STAGE(PG8_SA(0, 1), a2 + hstep, voffA);
            PG8_WAIT_L(8); PG8_BAR; PG8_WAIT_L(0); PG8_MMA(0, 0, At, B0); PG8_BAR; PG8_SCHED;
            PG8_LDB(B1, 1, 1); PG8_STAGE(PG8_SB(1, 0), b3, voffB);
            PG8_BAR; PG8_WAIT_L(0); PG8_MMA(0, 1, At, B1); PG8_BAR;
            PG8_LDA(At, 1, 1); PG8_STAGE(PG8_SA(1, 0), a3, voffA);
            PG8_BAR; PG8_WAIT_L(0); PG8_MMA(1, 0, At, B0); PG8_BAR; PG8_SCHED;
            PG8_STAGE(PG8_SB(1, 1), b3 + hstep, voffB);
            PG8_WAIT_V(6); PG8_BAR; PG8_MMA(1, 1, At, B1); PG8_BAR;
            }
        }
        if constexpr (ALIGN_EPI) { if (wr == 0) PG8_BAR; }
        if constexpr (!Epi::AFTER_DRAIN) { if constexpr (Epi::SSQ_LDS) E.epi(acc, cur, wr, wc, fr, fq, ui); else E(acc, cur, wr, wc, fr, fq); S.done(cur); }
        if (!has_next) break;
#pragma unroll
        for (int a = 0; a < 2; ++a)
#pragma unroll
            for (int b = 0; b < 2; ++b)
#pragma unroll
                for (int m = 0; m < 4; ++m)
#pragma unroll
                    for (int n = 0; n < 2; ++n) acc[a][b][m][n] = (f32x4){0.f, 0.f, 0.f, 0.f};
        cur = nxt; cA = nA; cB = nB; ++ui;
        if constexpr (ALIGN_EPI) { if (wr == 1) PG8_BAR; }
    }
    PG8_WAIT_V(0);
    if constexpr (!ALIGN_EPI) { if (wr == 0) PG8_BAR; }
    PG8_BAR;
    if constexpr (Epi::AFTER_DRAIN) { E.fused(acc, cur, wr, wc, fr, fq, lds, wid, lane); S.done(cur); }
#undef PG8_SA
#undef PG8_SB
#undef PG8_STAGE
#undef PG8_LDA
#undef PG8_LDB
#undef PG8_MMA
#undef PG8_WAIT_V
#undef PG8_WAIT_L
#undef PG8_BAR
#undef PG8_SCHED
}
}
#include <hip/hip_bf16.h>
#include <cmath>
namespace attn_body {
using bf16=__hip_bfloat16;
using bf16x8=__attribute__((ext_vector_type(8)))short;
using s16x4=__attribute__((ext_vector_type(4)))short;
using f32x16=__attribute__((ext_vector_type(16)))float;
using u32x4=__attribute__((ext_vector_type(4)))unsigned;
constexpr int D=64,QP=2048,OP=1024;
constexpr int NW=8,QBLK=32,QB=QBLK*NW,KVBLK=64;

__device__ __forceinline__ int crow(int r,int hi){return (r&3)+8*(r>>2)+4*hi;}
#define SBAR() __builtin_amdgcn_sched_barrier(0)
__device__ __forceinline__ void cmask(f32x16&p0,f32x16&p1,int jb,int qrel,int hi){
  const float NEG=-INFINITY; int kb=64*jb+4*hi;
  #pragma unroll
  for(int r=0;r<16;++r){int kv=kb+(r&3)+8*(r>>2); if(kv>qrel)p0[r]=NEG; if(kv+32>qrel)p1[r]=NEG;}
}

constexpr int NSLOT=3, SLOTB=8192;
constexpr int LDS_K=0, LDS_V=NSLOT*SLOTB, LDS_WS=2*NSLOT*SLOTB, LDS_OST=LDS_WS+NW*64*4, LDS_BYTES=LDS_OST+NW*4096;
constexpr float C2=0.125f*1.4426950408889634f;
__device__ __forceinline__ void glds16(const void*gsrc,unsigned lds_dst){unsigned keep;
  asm volatile("s_mov_b32 %0, m0\n\ts_mov_b32 m0, %2\n\ts_nop 0\n\tglobal_load_lds_dwordx4 %1, off\n\ts_mov_b32 m0, %0":"=&s"(keep):"v"(gsrc),"s"(lds_dst):"memory");}
__device__ __forceinline__ float max3f(float a,float b,float c){float r;asm("v_max3_f32 %0, %1, %2, %3":"=v"(r):"v"(a),"v"(b),"v"(c));return r;}
__device__ __forceinline__ float max2f(float a,float b){float r;asm("v_max_f32_e32 %0, %1, %2":"=v"(r):"v"(a),"v"(b));return r;}
__device__ __forceinline__ float fadd_s(float a,float b){float r;asm("v_add_f32_e32 %0, %1, %2":"=v"(r):"v"(a),"v"(b));return r;}
__device__ __forceinline__ float fsub_s(float a,float b){float r;asm("v_sub_f32_e32 %0, %1, %2":"=v"(r):"v"(a),"v"(b));return r;}
typedef float f32x2_t __attribute__((ext_vector_type(2))); typedef __bf16 bf16x2_t __attribute__((ext_vector_type(2)));
__device__ __forceinline__ unsigned cvtpk_s(float lo,float hi){f32x2_t v={lo,hi};bf16x2_t b=__builtin_convertvector(v,bf16x2_t);return __builtin_bit_cast(unsigned,b);}
#define WAIT_BAR(N) asm volatile("s_waitcnt vmcnt(" #N ") lgkmcnt(0)\n\ts_barrier":::"memory")

__device__ __forceinline__ void qkt(f32x16&p0,f32x16&p1,const char*Kslot,const bf16x8*qr,const f32x16&negm,int r32,int hi){
  const char*kb=Kslot+hi*1024+r32*16;
  #pragma unroll
  for(int d0=0;d0<4;++d0){
    const bf16x8 b0=*reinterpret_cast<const bf16x8*>(kb+d0*2048);
    const bf16x8 b1=*reinterpret_cast<const bf16x8*>(kb+d0*2048+512);
    if(d0==0){p0=__builtin_amdgcn_mfma_f32_32x32x16_bf16(b0,qr[0],negm,0,0,0);p1=__builtin_amdgcn_mfma_f32_32x32x16_bf16(b1,qr[0],negm,0,0,0);}
    else{p0=__builtin_amdgcn_mfma_f32_32x32x16_bf16(b0,qr[d0],p0,0,0,0);p1=__builtin_amdgcn_mfma_f32_32x32x16_bf16(b1,qr[d0],p1,0,0,0);}}
}
typedef __attribute__((address_space(3))) const char* lds_cptr;
typedef short v4i16_t __attribute__((ext_vector_type(4)));
__device__ __forceinline__ void kload8(bf16x8*kf,lds_cptr kp){
  kf[0]=*(const __attribute__((address_space(3))) bf16x8*)(kp);      kf[1]=*(const __attribute__((address_space(3))) bf16x8*)(kp+512);
  kf[2]=*(const __attribute__((address_space(3))) bf16x8*)(kp+2048); kf[3]=*(const __attribute__((address_space(3))) bf16x8*)(kp+2560);
  kf[4]=*(const __attribute__((address_space(3))) bf16x8*)(kp+4096); kf[5]=*(const __attribute__((address_space(3))) bf16x8*)(kp+4608);
  kf[6]=*(const __attribute__((address_space(3))) bf16x8*)(kp+6144); kf[7]=*(const __attribute__((address_space(3))) bf16x8*)(kp+6656);
}
__device__ __forceinline__ void kload2(bf16x8*kf,lds_cptr kp,int j){ kf[2*j]=*(const __attribute__((address_space(3))) bf16x8*)(kp+j*2048); kf[2*j+1]=*(const __attribute__((address_space(3))) bf16x8*)(kp+j*2048+512); }
__device__ __forceinline__ s16x4 vtr(lds_cptr p){ return __builtin_bit_cast(s16x4,__builtin_amdgcn_ds_read_tr16_b64_v4i16((__attribute__((address_space(3))) v4i16_t*)p)); }
__device__ __forceinline__ float rowmax(const f32x16&p0,const f32x16&p1){
  float a=max3f(p0[0],p0[1],p1[0]),b=max3f(p0[2],p0[3],p1[1]);a=max3f(a,p1[2],p1[3]);
  #pragma unroll
  for(int r=4;r<16;r+=4){a=max3f(a,p0[r],p0[r+1]);b=max3f(b,p0[r+2],p0[r+3]);a=max3f(a,p1[r],p1[r+1]);b=max3f(b,p1[r+2],p1[r+3]);}
  const float m=max2f(a,b);
  auto rr=__builtin_amdgcn_permlane32_swap(__float_as_uint(m),__float_as_uint(m),false,false);
  return max2f(__uint_as_float(rr[0]),__uint_as_float(rr[1]));
}
__device__ __forceinline__ void pv(f32x16*o,int vb,bf16x8 pa0,bf16x8 pa1,bf16x8 pa2,bf16x8 pa3){
  #pragma unroll
  for(int d0=0;d0<2;++d0){s16x4 lo[4],hi[4];
    #pragma unroll
    for(int ks=0;ks<4;++ks){
      asm volatile("ds_read_b64_tr_b16 %0,%1 offset:%c2":"=&v"(lo[ks]):"v"(vb),"i"(d0*4096+ks*1024):"memory");
      asm volatile("ds_read_b64_tr_b16 %0,%1 offset:%c2":"=&v"(hi[ks]):"v"(vb),"i"(d0*4096+ks*1024+512):"memory");}
    asm volatile("s_waitcnt lgkmcnt(0)":::"memory");SBAR();
    #define PK(k) (bf16x8){lo[k][0],lo[k][1],lo[k][2],lo[k][3],hi[k][0],hi[k][1],hi[k][2],hi[k][3]}
    o[d0]=__builtin_amdgcn_mfma_f32_32x32x16_bf16(pa0,PK(0),o[d0],0,0,0);
    o[d0]=__builtin_amdgcn_mfma_f32_32x32x16_bf16(pa1,PK(1),o[d0],0,0,0);
    o[d0]=__builtin_amdgcn_mfma_f32_32x32x16_bf16(pa2,PK(2),o[d0],0,0,0);
    o[d0]=__builtin_amdgcn_mfma_f32_32x32x16_bf16(pa3,PK(3),o[d0],0,0,0);
    #undef PK
  }
}

#ifndef ATTN_STORE16
#define ATTN_STORE16(p,v) (*(u32x4*)(p)=(v))
#endif
template<int THRL> __device__ __forceinline__ void attn_unit(long rowbase,int T,int h,int kvh,int qb,const bf16*__restrict__ QKV,bf16*Y,unsigned long long*ssqA,char*shm,float cref){
  int tid_=threadIdx.x; asm volatile("":"+v"(tid_)); const int tid=tid_,lane=tid&63,r32=lane&31,hi=lane>>5; const int wid=__builtin_amdgcn_readfirstlane(tid>>6);
  const int q0=qb*QB;
  const bf16*Qw=QKV+(rowbase+q0+wid*QBLK)*QP+h*D;
  const bf16*Kh=QKV+rowbase*QP+1024+kvh*D,*Vh=QKV+rowbase*QP+1536+kvh*D;
  const unsigned lds0=(unsigned)(uintptr_t)shm;
  float*wsf=(float*)(shm+LDS_WS)+wid*64;
  const bf16*ksrc=Kh+(long)lane*QP+wid*8;
  const bf16*vsrc=Vh+(long)(16*(wid&3)+(lane>>2))*QP+(wid>>2)*32+(lane&3)*8;
  const unsigned kdst=lds0+LDS_K+wid*1024, vdst=lds0+LDS_V+wid*1024;
  #define DMA_K(t,slot) glds16(ksrc+(long)(t)*KVBLK*QP,(unsigned)__builtin_amdgcn_readfirstlane(kdst+(slot)))
  #define DMA_V(t,slot) glds16(vsrc+(long)(t)*KVBLK*QP,(unsigned)__builtin_amdgcn_readfirstlane(vdst+(slot)))
  const int vb0=(int)(lds0+LDS_V)+((lane>>4)&1)*32+(lane&3)*8+(4*hi+((lane&15)>>2))*64;
  const char*Kbase=shm+LDS_K; bf16x8 kf[8];
  const lds_cptr shm3=(lds_cptr)shm; const lds_cptr kp0=shm3+LDS_K+hi*1024+r32*16; const lds_cptr vp0=shm3+LDS_V+((lane>>4)&1)*32+(lane&3)*8+(4*hi+((lane&15)>>2))*64;
  const int NT=T/KVBLK;
  DMA_K(0,0);DMA_V(0,0);DMA_K(1,SLOTB);
  bf16x8 qr[4];
  #pragma unroll
  for(int d0=0;d0<4;++d0)qr[d0]=*reinterpret_cast<const bf16x8*>(&Qw[(long)r32*QP+d0*16+hi*8]);
  float mhat=0.f,l_reg=0.f;f32x16 o[2];o[0]=f32x16{};o[1]=f32x16{};f32x16 negm;_Pragma("unroll") for(int r=0;r<16;++r)negm[r]=-cref;asm volatile("":"+v"(negm));
  const int qrel=wid*QBLK+r32;
  #define CMASK(P0,P1,t) do{}while(0)
  #define START(P0,P1) do{ _Pragma("unroll") for(int r=0;r<16;++r)P0[r]=__builtin_amdgcn_exp2f(P0[r]); }while(0)
  #define RESC() do{}while(0)
  f32x16 pA0,pA1,pB0,pB1;
  int sl_prev=0,sl_cur=0,sl_next=SLOTB;
  #define ROT() do{sl_prev=sl_cur;sl_cur=sl_next;sl_next=(sl_next==(NSLOT-1)*SLOTB)?0:sl_next+SLOTB;}while(0)
  DMA_K(2,2*SLOTB);
  WAIT_BAR(3);
  qkt(pA0,pA1,Kbase,qr,negm,r32,hi);asm volatile("s_nop 15\n\ts_nop 7":"+v"(pA0),"+v"(pA1));CMASK(pA0,pA1,0);
  START(pA0,pA1);
  _Pragma("unroll") for(int r=0;r<16;++r)pA1[r]=__builtin_amdgcn_exp2f(pA1[r]);
  WAIT_BAR(0);
  DMA_K(3,0);DMA_V(1,SLOTB);
  ROT();
  kload8(kf,kp0+sl_cur);
  WAIT_BAR(2);
  s16x4 vlo[8],vhi[8]; u32x4 pw0,pw1,pw2,pw3;
  #define PKW(P,B) cvtpk_s(P[B],P[B+1])
  #define PAF(k) __builtin_bit_cast(bf16x8,pw##k)
  #define VFR(i) (bf16x8){vlo[i][0],vlo[i][1],vlo[i][2],vlo[i][3],vhi[i][0],vhi[i][1],vhi[i][2],vhi[i][3]}
  #define PIN(x) asm volatile("":"+v"(x))
  #define MX3(a,b,c) __builtin_fmaxf(__builtin_fmaxf((a),(b)),(c))
  #define GAPA(MF,A0,A1,A2,A3,W0,W1,PW) do{ MF; sacc+=A0; sacc+=A1; sacc+=A2; sacc+=A3; PIN(sacc); W0; W1; PIN(PW); SBAR(); }while(0)
  #define EX(v) __builtin_amdgcn_exp2f(v)
  #define GAPB(MF,X,B) do{ MF; X[B]=EX(X[B]); X[B+1]=EX(X[B+1]); X[B+2]=EX(X[B+2]); X[B+3]=EX(X[B+3]); PIN(X); SBAR(); }while(0)
  #define VRD(i) do{ vlo[i]=vtr(vp_+(((i)>>2)*4096+((i)&3)*1024)); vhi[i]=vtr(vp_+(((i)>>2)*4096+((i)&3)*1024+512)); }while(0)
  #define KRD(G,j) do{ if(G){ kload2(kf,kp0+sl_next,j); SBAR(); } }while(0)
  #define STEP(C0,C1,P0,P1,t,GK,GV,GL) do{ SBAR(); \
    const lds_cptr vp_=vp0+sl_prev; \
    VRD(0); SBAR(); float sacc=(P0[0]+P0[1]); \
    GAPA(C0=__builtin_amdgcn_mfma_f32_32x32x16_bf16(kf[0],qr[0],negm,0,0,0), P0[2],P0[3],P0[4],P0[5],     pw0[0]=PKW(P0,0), pw0[1]=PKW(P0,2), pw0); \
    VRD(4); SBAR(); GAPA(C1=__builtin_amdgcn_mfma_f32_32x32x16_bf16(kf[1],qr[0],negm,0,0,0), P0[6],P0[7],P0[8],P0[9],     pw0[2]=PKW(P0,4), pw0[3]=PKW(P0,6), pw0); \
    VRD(1); SBAR(); GAPA(C0=__builtin_amdgcn_mfma_f32_32x32x16_bf16(kf[2],qr[1],C0,0,0,0),   P0[10],P0[11],P0[12],P0[13], pw1[0]=PKW(P0,8), pw1[1]=PKW(P0,10), pw1); \
    VRD(5); SBAR(); GAPA(C1=__builtin_amdgcn_mfma_f32_32x32x16_bf16(kf[3],qr[1],C1,0,0,0),   P0[14],P0[15],P1[0],P1[1],   pw1[2]=PKW(P0,12),pw1[3]=PKW(P0,14), pw1); \
    VRD(2); SBAR(); GAPA(C0=__builtin_amdgcn_mfma_f32_32x32x16_bf16(kf[4],qr[2],C0,0,0,0),   P1[2],P1[3],P1[4],P1[5],     pw2[0]=PKW(P1,0), pw2[1]=PKW(P1,2), pw2); \
    VRD(6); SBAR(); GAPA(C1=__builtin_amdgcn_mfma_f32_32x32x16_bf16(kf[5],qr[2],C1,0,0,0),   P1[6],P1[7],P1[8],P1[9],     pw2[2]=PKW(P1,4), pw2[3]=PKW(P1,6), pw2); \
    VRD(3); SBAR(); GAPA(C0=__builtin_amdgcn_mfma_f32_32x32x16_bf16(kf[6],qr[3],C0,0,0,0),   P1[10],P1[11],P1[12],P1[13], pw3[0]=PKW(P1,8), pw3[1]=PKW(P1,10), pw3); \
    VRD(7); SBAR(); GAPA(C1=__builtin_amdgcn_mfma_f32_32x32x16_bf16(kf[7],qr[3],C1,0,0,0),   P1[14],P1[15],0.f,0.f,       pw3[2]=PKW(P1,12),pw3[3]=PKW(P1,14), pw3); \
    l_reg+=sacc; \
    if(GK){DMA_K((t)+3,sl_cur);} if(GV){DMA_V((t)+1,sl_next);} \
    CMASK(C0,C1,t); \
    SBAR(); \
    GAPB(o[0]=__builtin_amdgcn_mfma_f32_32x32x16_bf16(PAF(0),VFR(0),o[0],0,0,0), C0,0); \
    GAPB(o[1]=__builtin_amdgcn_mfma_f32_32x32x16_bf16(PAF(0),VFR(4),o[1],0,0,0), C0,4); \
    KRD(GL,0); GAPB(o[0]=__builtin_amdgcn_mfma_f32_32x32x16_bf16(PAF(1),VFR(1),o[0],0,0,0), C0,8); \
    KRD(GL,1); GAPB(o[1]=__builtin_amdgcn_mfma_f32_32x32x16_bf16(PAF(1),VFR(5),o[1],0,0,0), C0,12); \
    KRD(GL,2); GAPB(o[0]=__builtin_amdgcn_mfma_f32_32x32x16_bf16(PAF(2),VFR(2),o[0],0,0,0), C1,0); \
    KRD(GL,3); GAPB(o[1]=__builtin_amdgcn_mfma_f32_32x32x16_bf16(PAF(2),VFR(6),o[1],0,0,0), C1,4); \
    GAPB(o[0]=__builtin_amdgcn_mfma_f32_32x32x16_bf16(PAF(3),VFR(3),o[0],0,0,0), C1,8); \
    GAPB(o[1]=__builtin_amdgcn_mfma_f32_32x32x16_bf16(PAF(3),VFR(7),o[1],0,0,0), C1,12); \
    }while(0)
  int t=1;
  #undef CMASK
  #define CMASK(P0,P1,t) do{}while(0)
  for(;t+5<NT;t+=2){
    STEP(pB0,pB1,pA0,pA1,t,true,true,true);     WAIT_BAR(2); RESC(); ROT();
    STEP(pA0,pA1,pB0,pB1,t+1,true,true,true);   WAIT_BAR(2); RESC(); ROT();
  }
  #undef CMASK
  #define CMASK(P0,P1,t) do{}while(0)
  #define ENDW(tt) do{ if((tt)+3<NT){WAIT_BAR(2);} else if((tt)+2<NT){WAIT_BAR(1);} else {WAIT_BAR(0);} }while(0)
  for(;t+1<NT;t+=2){
    STEP(pB0,pB1,pA0,pA1,t,(t+3<NT),(t+1<NT),(t+1<NT));       ENDW(t);   RESC(); ROT();
    STEP(pA0,pA1,pB0,pB1,t+1,(t+4<NT),(t+2<NT),(t+2<NT));     ENDW(t+1); RESC(); ROT();
  }
  STEP(pB0,pB1,pA0,pA1,NT-1,false,false,false); RESC();
  { float sacc=pB0[0]+pB0[1]; _Pragma("unroll") for(int r=2;r<16;++r)sacc+=pB0[r]; _Pragma("unroll") for(int r=0;r<16;++r)sacc+=pB1[r]; l_reg+=sacc;
    pw0=(u32x4){PKW(pB0,0),PKW(pB0,2),PKW(pB0,4),PKW(pB0,6)};pw1=(u32x4){PKW(pB0,8),PKW(pB0,10),PKW(pB0,12),PKW(pB0,14)};pw2=(u32x4){PKW(pB1,0),PKW(pB1,2),PKW(pB1,4),PKW(pB1,6)};pw3=(u32x4){PKW(pB1,8),PKW(pB1,10),PKW(pB1,12),PKW(pB1,14)};
    SBAR(); pv(o,vb0+sl_cur,PAF(0),PAF(1),PAF(2),PAF(3)); }
  #undef PKW
  #undef PAF
  #undef VFR
  #undef PIN
  #undef MX3
  #undef GAPA
  #undef GAPB
  #undef EX
  #undef VRD
  #undef KRD
  #undef STEP
  #undef ENDW
  {auto rr=__builtin_amdgcn_permlane32_swap(__float_as_uint(l_reg),__float_as_uint(l_reg),false,false);l_reg=__uint_as_float(rr[0])+__uint_as_float(rr[1]);}
  if(hi==0)wsf[32+r32]=l_reg;asm volatile("s_waitcnt lgkmcnt(0)":::"memory");
  float rli[16];
  #pragma unroll
  for(int r=0;r<16;++r)rli[r]=__builtin_amdgcn_rcpf(wsf[32+crow(r,hi)]);
  bf16*Ow=Y+(rowbase+q0+wid*QBLK)*OP+h*D; unsigned long long*sqw=ssqA+rowbase+q0+wid*QBLK;
  { bf16*stg=(bf16*)(shm+LDS_OST)+wid*2048;
    #pragma unroll
    for(int r=0;r<16;++r){const int orow=crow(r,hi);
      #pragma unroll
      for(int d0=0;d0<2;++d0)stg[orow*64+d0*32+r32]=__float2bfloat16(o[d0][r]*rli[r]);}
    asm volatile("s_waitcnt lgkmcnt(0)":::"memory");
    #pragma unroll
    for(int i=0;i<4;++i){const int row=i*8+(lane>>3),ch=lane&7; const u32x4 v=*(const u32x4*)(stg+row*64+ch*8); ATTN_STORE16(Ow+(long)row*OP+ch*8,v);
      float ss=0.f;
      #pragma unroll
      for(int w_=0;w_<4;++w_){const float a_=__uint_as_float(v[w_]<<16),b_=__uint_as_float(v[w_]&0xffff0000u);ss+=a_*a_+b_*b_;}
      ss+=__shfl_xor(ss,1);ss+=__shfl_xor(ss,2);ss+=__shfl_xor(ss,4); if(ch==0)atomicAdd(sqw+row,(unsigned long long)(ss*1073741824.0f));} }
  asm volatile("s_waitcnt lgkmcnt(0)\n\ts_barrier":::"memory");
  #undef DMA_K
  #undef DMA_V
  #undef CMASK
  #undef START
  #undef RESC
  #undef ROT
}
constexpr int ATTN_LDS_BYTES=LDS_BYTES;
#undef SBAR
#undef WAIT_BAR
}
namespace loc {
typedef unsigned short bf16_t;
typedef short bf16x8 __attribute__((ext_vector_type(8)));
typedef short s16x4 __attribute__((ext_vector_type(4)));
typedef float f32x4 __attribute__((ext_vector_type(4)));
typedef unsigned u32x4 __attribute__((ext_vector_type(4)));
typedef unsigned u32x2 __attribute__((ext_vector_type(2)));
#define LOC_LAS __attribute__((address_space(3)))
constexpr int VPITCH = 144;
constexpr int VBUF_BYTES = 32 * VPITCH;
__device__ __forceinline__ s16x4 trd(LOC_LAS char* p) { return __builtin_bit_cast(s16x4, __builtin_amdgcn_ds_read_tr16_b64_v4i16((LOC_LAS s16x4*)p)); }
typedef float f32x2_t __attribute__((ext_vector_type(2))); typedef __bf16 bf16x2_t __attribute__((ext_vector_type(2)));
__device__ __forceinline__ unsigned pk2(float lo, float hi) { f32x2_t v = {lo, hi}; bf16x2_t b = __builtin_convertvector(v, bf16x2_t); return __builtin_bit_cast(unsigned, b); }
__device__ __forceinline__ int clampi(int v, int lo, int hi) { return v < lo ? lo : (v > hi ? hi : v); }

template <int MIX>
__device__ __forceinline__ void local_unit(const bf16_t* __restrict__ QKV, const bf16_t* __restrict__ KVC, bf16_t* Y, const LOC_LAS float* rpbL, LOC_LAS char* vbuf,
                                           long seqrow, int T, int q0, int lane, float negC, LOC_LAS char* img, int rho_l, int imgpos0) {
    const int fr = lane & 15, g = lane >> 4;
    constexpr int QS = (MIX == 1) ? 1 : 16;
    const int qpos = q0 + QS * fr;
    float ss = 0.f;
#pragma unroll 1
    for (int pair = 0; pair < 3; ++pair) {
    const int qh0 = (MIX == 1 ? 4 : 10) + 2 * pair, kvh = (MIX == 1 ? 2 : 5) + pair;
    const bf16_t* qrow = QKV + (size_t)(seqrow + qpos) * 2048 + qh0 * 64 + 8 * g;
    bf16x8 qf[2][2];
#pragma unroll
    for (int h = 0; h < 2; ++h)
#pragma unroll
        for (int ks = 0; ks < 2; ++ks) qf[h][ks] = *(const bf16x8*)(qrow + h * 64 + 32 * ks);
    f32x4 o[2][4];
#pragma unroll
    for (int h = 0; h < 2; ++h)
#pragma unroll
        for (int c = 0; c < 4; ++c) o[h][c] = (f32x4){0.f, 0.f, 0.f, 0.f};
    float ls[2] = {0.f, 0.f};
    const int kvl = (MIX == 1 ? 0 : 3) + pair;
    const bf16_t* Kb = KVC + ((size_t)kvl * 49152 + seqrow) * 128 + 8 * g;
    const bf16_t* Vb = KVC + ((size_t)kvl * 49152 + seqrow) * 128 + 64 + (lane & 7) * 8;
    constexpr int NTILES = (MIX == 1) ? 8 : 23;
    constexpr int NG = (MIX == 1) ? 8 : 11;
    if (MIX == 2) {
        __syncthreads();
        const int t512 = rho_l * 64 + lane;
        const bf16_t* src = KVC + ((size_t)kvl * 49152 + seqrow) * 128;
        u32x4 w[12];
#pragma unroll
        for (int j = 0; j < 12; ++j) { const int cch = t512 + 512 * j, key = cch >> 4, part = cch & 15; const int kp = clampi(imgpos0 + key, 0, T - 1); w[j] = *(const u32x4*)(src + (size_t)kp * 128 + part * 8); }
#pragma unroll
        for (int j = 0; j < 12; ++j) { const int cch = t512 + 512 * j, key = cch >> 4, part = cch & 15;
            LOC_LAS char* d = (part < 8) ? img + key * 128 + ((part ^ (key & 7)) * 16) : img + 49152 + key * 128 + (((((part - 8) >> 1) ^ ((key >> 1) & 3)) * 2 + (part & 1)) * 16);
            *(LOC_LAS u32x4*)d = w[j]; }
        __syncthreads();
    }
    const int r = q0 >> 6, c = (q0 & 63) + fr, c0 = clampi(c - 8, 0, 48), r0 = clampi(r - 4, 0, (T >> 6) - 8), jq = (q0 & 63) >> 4;
    const int cb = jq == 0 ? 0 : (jq == 1 ? 8 : (jq == 2 ? 24 : 32));
    LOC_LAS char* vwr = vbuf + (lane >> 3) * VPITCH + (lane & 7) * 16;
    LOC_LAS char* vrd = vbuf + (4 * g + ((lane & 15) >> 2)) * VPITCH + (lane & 3) * 8;
    bf16x8 kn[2][2]; u32x4 vn[4];
#define LOC_TILE(it_, base_, s_) do { if (MIX == 1) { base_ = (r0 + (it_)) * 64 + cb; s_ = 1; } \
        else { if ((it_) < 5) { s_ = 16; base_ = q0 - 1024 + 512 * (it_); } else if ((it_) < 11) { s_ = 4; base_ = q0 - 256 + 128 * ((it_) - 5); } else { s_ = 1; base_ = q0 - 64 + 32 * ((it_) - 11); } } } while (0)
#define LOC_ISSUE(it_) do { int b_, s_; LOC_TILE(it_, b_, s_); \
        _Pragma("unroll") for (int ab = 0; ab < 2; ++ab) { const int kp = clampi(b_ + s_ * (16 * ab + fr), 0, T - 1); const bf16_t* p = Kb + (size_t)kp * 128; kn[ab][0] = *(const bf16x8*)p; kn[ab][1] = *(const bf16x8*)(p + 32); } \
        _Pragma("unroll") for (int i_ = 0; i_ < 4; ++i_) { const int kp = clampi(b_ + s_ * (8 * i_ + (lane >> 3)), 0, T - 1); vn[i_] = *(const u32x4*)(Vb + (size_t)kp * 128); } } while (0)
    LOC_ISSUE(0);
    for (int it = 0; it < NG; ++it) {
        int base, s; LOC_TILE(it, base, s);
        bf16x8 kf[2][2];
        constexpr bool fromimg = false;
        const int kbase = rho_l + 32 * (it - NG);
        if (!fromimg) {
#pragma unroll
            for (int ab = 0; ab < 2; ++ab) { kf[ab][0] = kn[ab][0]; kf[ab][1] = kn[ab][1]; }
            const u32x4 v0 = vn[0], v1 = vn[1], v2 = vn[2], v3 = vn[3];
            asm volatile("" : : "v"(kf[0][0]), "v"(kf[0][1]), "v"(kf[1][0]), "v"(kf[1][1]), "v"(v0), "v"(v1), "v"(v2), "v"(v3) : "memory");
            *(LOC_LAS u32x4*)(vwr) = v0; *(LOC_LAS u32x4*)(vwr + 8 * VPITCH) = v1; *(LOC_LAS u32x4*)(vwr + 16 * VPITCH) = v2; *(LOC_LAS u32x4*)(vwr + 24 * VPITCH) = v3;
            if (it + 1 < NG) LOC_ISSUE(it + 1);
        } else {
#pragma unroll
            for (int ab = 0; ab < 2; ++ab) { const int k = clampi(kbase + 16 * ab + fr, 0, 383); const LOC_LAS char* p = img + k * 128;
                kf[ab][0] = *(const LOC_LAS bf16x8*)(p + (((0 + g) ^ (k & 7)) * 16)); kf[ab][1] = *(const LOC_LAS bf16x8*)(p + (((4 + g) ^ (k & 7)) * 16)); }
        }
        asm volatile("" ::: "memory");
        f32x4 ini[2][2];
#pragma unroll
        for (int ab = 0; ab < 2; ++ab)
#pragma unroll
            for (int e = 0; e < 4; ++e) { const int j = 16 * ab + 4 * g + e;
                if (MIX == 1) { const int kc = cb + j; const bool valid = (unsigned)(kc - c0) < 16u; const int bidx = valid ? ((r0 + it - r + 7) * 31 + (kc - c + 15)) : 0;
                    float b0 = rpbL[(2 * pair) * 465 + bidx], b1 = rpbL[(2 * pair + 1) * 465 + bidx]; asm volatile("" : "+v"(b0), "+v"(b1));
                    ini[0][ab][e] = valid ? b0 : -1e30f; ini[1][ab][e] = valid ? b1 : -1e30f; }
                else { const int kp = base + s * j; const int dd = kp - qpos; const bool valid = ((unsigned)kp < (unsigned)T) & ((unsigned)(dd + 64 * s) <= (unsigned)(128 * s));
                    ini[0][ab][e] = valid ? negC : -1e30f; ini[1][ab][e] = ini[0][ab][e]; } }
        f32x4 sc[2][2];
#pragma unroll
        for (int h = 0; h < 2; ++h)
#pragma unroll
            for (int ab = 0; ab < 2; ++ab) { sc[h][ab] = __builtin_amdgcn_mfma_f32_16x16x32_bf16(kf[ab][0], qf[h][0], ini[h][ab], 0, 0, 0);
                sc[h][ab] = __builtin_amdgcn_mfma_f32_16x16x32_bf16(kf[ab][1], qf[h][1], sc[h][ab], 0, 0, 0); }
        bf16x8 vf[4];
#pragma unroll
        for (int cc = 0; cc < 4; ++cc) { LOC_LAS char* plo = vrd + cc * 32; LOC_LAS char* phi = vrd + 16 * VPITCH + cc * 32;
            if (fromimg) { const int qq = (lane & 15) >> 2, rlo = clampi(kbase + 4 * g + qq, 0, 383), rhi = clampi(kbase + 16 + 4 * g + qq, 0, 383);
                plo = img + 49152 + rlo * 128 + ((cc ^ ((rlo >> 1) & 3)) * 32) + (lane & 3) * 8; phi = img + 49152 + rhi * 128 + ((cc ^ ((rhi >> 1) & 3)) * 32) + (lane & 3) * 8; }
            const s16x4 lo = trd(plo), hi = trd(phi); vf[cc] = (bf16x8){lo[0], lo[1], lo[2], lo[3], hi[0], hi[1], hi[2], hi[3]}; }
        bf16x8 pf[2];
#pragma unroll
        for (int h = 0; h < 2; ++h) {
            float p[2][4]; float psum = 0.f;
#pragma unroll
            for (int ab = 0; ab < 2; ++ab)
#pragma unroll
                for (int e = 0; e < 4; ++e) { p[ab][e] = __builtin_amdgcn_exp2f(sc[h][ab][e]); psum += p[ab][e]; }
            ls[h] += psum;
            u32x4 w; w.x = pk2(p[0][0], p[0][1]); w.y = pk2(p[0][2], p[0][3]); w.z = pk2(p[1][0], p[1][1]); w.w = pk2(p[1][2], p[1][3]);
            pf[h] = __builtin_bit_cast(bf16x8, w);
        }
#pragma unroll
        for (int cc = 0; cc < 4; ++cc) {
            o[0][cc] = __builtin_amdgcn_mfma_f32_16x16x32_bf16(vf[cc], pf[0], o[0][cc], 0, 0, 0);
            o[1][cc] = __builtin_amdgcn_mfma_f32_16x16x32_bf16(vf[cc], pf[1], o[1][cc], 0, 0, 0);
        }
        asm volatile("" ::: "memory");
    }
    if (MIX == 2) {
#pragma unroll 4
    for (int it = NG; it < NTILES; ++it) {
        int base, s; LOC_TILE(it, base, s);
        bf16x8 kf[2][2];
        constexpr bool fromimg = true;
        const int kbase = rho_l + 32 * (it - NG);
        if (!fromimg) {
#pragma unroll
            for (int ab = 0; ab < 2; ++ab) { kf[ab][0] = kn[ab][0]; kf[ab][1] = kn[ab][1]; }
            const u32x4 v0 = vn[0], v1 = vn[1], v2 = vn[2], v3 = vn[3];
            asm volatile("" : : "v"(kf[0][0]), "v"(kf[0][1]), "v"(kf[1][0]), "v"(kf[1][1]), "v"(v0), "v"(v1), "v"(v2), "v"(v3) : "memory");
            *(LOC_LAS u32x4*)(vwr) = v0; *(LOC_LAS u32x4*)(vwr + 8 * VPITCH) = v1; *(LOC_LAS u32x4*)(vwr + 16 * VPITCH) = v2; *(LOC_LAS u32x4*)(vwr + 24 * VPITCH) = v3;
            if (it + 1 < NG) LOC_ISSUE(it + 1);
        } else {
#pragma unroll
            for (int ab = 0; ab < 2; ++ab) { const int k = clampi(kbase + 16 * ab + fr, 0, 383); const LOC_LAS char* p = img + k * 128;
                kf[ab][0] = *(const LOC_LAS bf16x8*)(p + (((0 + g) ^ (k & 7)) * 16)); kf[ab][1] = *(const LOC_LAS bf16x8*)(p + (((4 + g) ^ (k & 7)) * 16)); }
        }
        f32x4 ini[2][2];
#pragma unroll
        for (int ab = 0; ab < 2; ++ab)
#pragma unroll
            for (int e = 0; e < 4; ++e) { const int j = 16 * ab + 4 * g + e;
                if (MIX == 1) { const int kc = cb + j; const bool valid = (unsigned)(kc - c0) < 16u; const int bidx = valid ? ((r0 + it - r + 7) * 31 + (kc - c + 15)) : 0;
                    float b0 = rpbL[(2 * pair) * 465 + bidx], b1 = rpbL[(2 * pair + 1) * 465 + bidx]; asm volatile("" : "+v"(b0), "+v"(b1));
                    ini[0][ab][e] = valid ? b0 : -1e30f; ini[1][ab][e] = valid ? b1 : -1e30f; }
                else { const int kp = base + s * j; const int dd = kp - qpos; const bool valid = ((unsigned)kp < (unsigned)T) & ((unsigned)(dd + 64 * s) <= (unsigned)(128 * s));
                    ini[0][ab][e] = valid ? negC : -1e30f; ini[1][ab][e] = ini[0][ab][e]; } }
        f32x4 sc[2][2];
#pragma unroll
        for (int h = 0; h < 2; ++h)
#pragma unroll
            for (int ab = 0; ab < 2; ++ab) { sc[h][ab] = __builtin_amdgcn_mfma_f32_16x16x32_bf16(kf[ab][0], qf[h][0], ini[h][ab], 0, 0, 0);
                sc[h][ab] = __builtin_amdgcn_mfma_f32_16x16x32_bf16(kf[ab][1], qf[h][1], sc[h][ab], 0, 0, 0); }
        bf16x8 vf[4];
#pragma unroll
        for (int cc = 0; cc < 4; ++cc) { LOC_LAS char* plo = vrd + cc * 32; LOC_LAS char* phi = vrd + 16 * VPITCH + cc * 32;
            if (fromimg) { const int qq = (lane & 15) >> 2, rlo = clampi(kbase + 4 * g + qq, 0, 383), rhi = clampi(kbase + 16 + 4 * g + qq, 0, 383);
                plo = img + 49152 + rlo * 128 + ((cc ^ ((rlo >> 1) & 3)) * 32) + (lane & 3) * 8; phi = img + 49152 + rhi * 128 + ((cc ^ ((rhi >> 1) & 3)) * 32) + (lane & 3) * 8; }
            const s16x4 lo = trd(plo), hi = trd(phi); vf[cc] = (bf16x8){lo[0], lo[1], lo[2], lo[3], hi[0], hi[1], hi[2], hi[3]}; }
        bf16x8 pf[2];
#pragma unroll
        for (int h = 0; h < 2; ++h) {
            float p[2][4]; float psum = 0.f;
#pragma unroll
            for (int ab = 0; ab < 2; ++ab)
#pragma unroll
                for (int e = 0; e < 4; ++e) { p[ab][e] = __builtin_amdgcn_exp2f(sc[h][ab][e]); psum += p[ab][e]; }
            ls[h] += psum;
            u32x4 w; w.x = pk2(p[0][0], p[0][1]); w.y = pk2(p[0][2], p[0][3]); w.z = pk2(p[1][0], p[1][1]); w.w = pk2(p[1][2], p[1][3]);
            pf[h] = __builtin_bit_cast(bf16x8, w);
        }
#pragma unroll
        for (int cc = 0; cc < 4; ++cc) {
            o[0][cc] = __builtin_amdgcn_mfma_f32_16x16x32_bf16(vf[cc], pf[0], o[0][cc], 0, 0, 0);
            o[1][cc] = __builtin_amdgcn_mfma_f32_16x16x32_bf16(vf[cc], pf[1], o[1][cc], 0, 0, 0);
        }
    }
    }
    bf16_t* yrow = Y + (size_t)(seqrow + qpos) * 1024 + qh0 * 64 + 4 * g;
#pragma unroll
    for (int h = 0; h < 2; ++h) {
        float l = ls[h]; l += __shfl_xor(l, 16); l += __shfl_xor(l, 32);
        const float inv = 1.0f / l;
#pragma unroll
        for (int cc = 0; cc < 4; ++cc) { const f32x4 v = o[h][cc] * inv; u32x2 w; w.x = pk2(v[0], v[1]); w.y = pk2(v[2], v[3]);
            *(u32x2*)(yrow + h * 64 + 16 * cc) = w;
            const float a0 = __uint_as_float(w.x << 16), a1 = __uint_as_float(w.x & 0xffff0000u), a2 = __uint_as_float(w.y << 16), a3 = __uint_as_float(w.y & 0xffff0000u);
            ss += (a0 * a0 + a1 * a1) + (a2 * a2 + a3 * a3); }
    }
    }
    ss += __shfl_xor(ss, 16); ss += __shfl_xor(ss, 32);
    const float f = rsqrtf(ss * (1.0f / 384.0f) + 1e-6f);
    asm volatile("s_waitcnt vmcnt(0)" ::: "memory");
    { bf16_t* yb = Y + (size_t)(seqrow + qpos) * 1024 + (MIX == 1 ? 4 : 10) * 64 + 4 * g;
      u32x2 w[24];
#pragma unroll
      for (int i = 0; i < 24; ++i) w[i] = *(const u32x2*)(yb + 16 * i);
#pragma unroll
      for (int i = 0; i < 24; ++i) { u32x2 v = w[i]; v.x = pk2(__uint_as_float(v.x << 16) * f, __uint_as_float(v.x & 0xffff0000u) * f); v.y = pk2(__uint_as_float(v.y << 16) * f, __uint_as_float(v.y & 0xffff0000u) * f);
          *(u32x2*)(yb + 16 * i) = v; } }
}
#undef LOC_TILE
#undef LOC_ISSUE

__device__ __forceinline__ void local_unit_nb(const bf16_t* __restrict__ QKV, const bf16_t* __restrict__ KVC, bf16_t* Y, const LOC_LAS float* rpbL, LOC_LAS char* img,
                                              long seqrow, int T, int gr0, int wave, int lane) {
    const int fr = lane & 15, g = lane >> 4;
    const int rows = T >> 6;
    const int r = gr0 + (wave >> 2), jq = wave & 3;
    const int q0 = r * 64 + 16 * jq, qpos = q0 + fr;
    const int c = 16 * jq + fr, c0 = clampi(c - 8, 0, 48), r0 = clampi(r - 4, 0, rows - 8);
    const int cb = jq == 0 ? 0 : (jq == 1 ? 8 : (jq == 2 ? 24 : 32));
    const int R0 = clampi(gr0 - 4, 0, rows - 8);
    const int t512 = wave * 64 + lane;
    const bf16_t* src0 = KVC + (size_t)seqrow * 128;
    float ss = 0.f;
    u32x4 w[6];
#define NB_LOAD(q_) do { const bf16_t* s_ = src0 + (size_t)((q_) / 3) * 49152 * 128; const int p0_ = (R0 + 3 * ((q_) % 3)) * 64; \
        _Pragma("unroll") for (int j = 0; j < 6; ++j) { const int cch = t512 + 512 * j, key = cch >> 4, part = cch & 15; const int kp = clampi(p0_ + key, 0, T - 1); w[j] = *(const u32x4*)(s_ + (size_t)kp * 128 + part * 8); } } while (0)
#define NB_STORE(q_) do { LOC_LAS char* b_ = img + ((q_) & 1) * 49152; \
        _Pragma("unroll") for (int j = 0; j < 6; ++j) { const int cch = t512 + 512 * j, key = cch >> 4, part = cch & 15; \
            LOC_LAS char* d = (part < 8) ? b_ + key * 128 + ((part ^ (key & 7)) * 16) : b_ + 24576 + key * 128 + (((((part - 8) >> 1) ^ ((key >> 1) & 3)) * 2 + (part & 1)) * 16); \
            *(LOC_LAS u32x4*)d = w[j]; } } while (0)
    __syncthreads();
    NB_LOAD(0); NB_STORE(0);
    __syncthreads();
    bf16x8 qf[2][2]; f32x4 o[2][4]; float ls[2];
#pragma unroll 1
    for (int q = 0; q < 9; ++q) {
        const int pair = q / 3, pass = q - 3 * pair;
        if (q + 1 < 9) NB_LOAD(q + 1);
        if (pass == 0) {
            const bf16_t* qrow = QKV + (size_t)(seqrow + qpos) * 2048 + (4 + 2 * pair) * 64 + 8 * g;
#pragma unroll
            for (int h = 0; h < 2; ++h)
#pragma unroll
                for (int ks = 0; ks < 2; ++ks) qf[h][ks] = *(const bf16x8*)(qrow + h * 64 + 32 * ks);
#pragma unroll
            for (int h = 0; h < 2; ++h)
#pragma unroll
                for (int cc = 0; cc < 4; ++cc) o[h][cc] = (f32x4){0.f, 0.f, 0.f, 0.f};
            ls[0] = 0.f; ls[1] = 0.f;
        }
        LOC_LAS char* ib = img + (q & 1) * 49152;
        const int Rp = R0 + 3 * pass;
        const int klo = r0 > Rp ? r0 : Rp, khi = (r0 + 8 < Rp + 3) ? r0 + 8 : Rp + 3;
#pragma unroll 3
        for (int kr = klo; kr < khi; ++kr) {
            const int kbase = (kr - Rp) * 64 + cb;
            bf16x8 kf[2][2];
#pragma unroll
            for (int ab = 0; ab < 2; ++ab) { const int k = kbase + 16 * ab + fr; const LOC_LAS char* p = ib + k * 128;
                kf[ab][0] = *(const LOC_LAS bf16x8*)(p + (((0 + g) ^ (k & 7)) * 16)); kf[ab][1] = *(const LOC_LAS bf16x8*)(p + (((4 + g) ^ (k & 7)) * 16)); }
            f32x4 ini[2][2];
#pragma unroll
            for (int ab = 0; ab < 2; ++ab)
#pragma unroll
                for (int e = 0; e < 4; ++e) { const int kc = cb + 16 * ab + 4 * g + e; const bool valid = (unsigned)(kc - c0) < 16u; const int bidx = valid ? ((kr - r + 7) * 31 + (kc - c + 15)) : 0;
                    ini[0][ab][e] = rpbL[(2 * pair) * 465 + bidx]; ini[1][ab][e] = rpbL[(2 * pair + 1) * 465 + bidx]; }
            asm volatile("" : "+v"(ini[0][0]), "+v"(ini[0][1]), "+v"(ini[1][0]), "+v"(ini[1][1]));
#pragma unroll
            for (int ab = 0; ab < 2; ++ab)
#pragma unroll
                for (int e = 0; e < 4; ++e) { const int kc = cb + 16 * ab + 4 * g + e; const bool valid = (unsigned)(kc - c0) < 16u;
                    ini[0][ab][e] = valid ? ini[0][ab][e] : -1e30f; ini[1][ab][e] = valid ? ini[1][ab][e] : -1e30f; }
            f32x4 sc[2][2];
#pragma unroll
            for (int h = 0; h < 2; ++h)
#pragma unroll
                for (int ab = 0; ab < 2; ++ab) { sc[h][ab] = __builtin_amdgcn_mfma_f32_16x16x32_bf16(kf[ab][0], qf[h][0], ini[h][ab], 0, 0, 0);
                    sc[h][ab] = __builtin_amdgcn_mfma_f32_16x16x32_bf16(kf[ab][1], qf[h][1], sc[h][ab], 0, 0, 0); }
            bf16x8 vf[4];
#pragma unroll
            for (int cc = 0; cc < 4; ++cc) { const int qq = (lane & 15) >> 2; const int rlo = kbase + 4 * g + qq, rhi = rlo + 16;
                LOC_LAS char* plo = ib + 24576 + rlo * 128 + ((cc ^ ((rlo >> 1) & 3)) * 32) + (lane & 3) * 8; LOC_LAS char* phi = ib + 24576 + rhi * 128 + ((cc ^ ((rhi >> 1) & 3)) * 32) + (lane & 3) * 8;
                const s16x4 lo = trd(plo), hi = trd(phi); vf[cc] = (bf16x8){lo[0], lo[1], lo[2], lo[3], hi[0], hi[1], hi[2], hi[3]}; }
            bf16x8 pf[2];
#pragma unroll
            for (int h = 0; h < 2; ++h) {
                float p[2][4]; float psum = 0.f;
#pragma unroll
                for (int ab = 0; ab < 2; ++ab)
#pragma unroll
                    for (int e = 0; e < 4; ++e) { p[ab][e] = __builtin_amdgcn_exp2f(sc[h][ab][e]); psum += p[ab][e]; }
                ls[h] += psum;
                u32x4 w_; w_.x = pk2(p[0][0], p[0][1]); w_.y = pk2(p[0][2], p[0][3]); w_.z = pk2(p[1][0], p[1][1]); w_.w = pk2(p[1][2], p[1][3]);
                pf[h] = __builtin_bit_cast(bf16x8, w_);
            }
#pragma unroll
            for (int cc = 0; cc < 4; ++cc) {
                o[0][cc] = __builtin_amdgcn_mfma_f32_16x16x32_bf16(vf[cc], pf[0], o[0][cc], 0, 0, 0);
                o[1][cc] = __builtin_amdgcn_mfma_f32_16x16x32_bf16(vf[cc], pf[1], o[1][cc], 0, 0, 0);
            }
        }
        if (pass == 2) {
            bf16_t* yrow = Y + (size_t)(seqrow + qpos) * 1024 + (4 + 2 * pair) * 64 + 4 * g;
#pragma unroll
            for (int h = 0; h < 2; ++h) {
                float l_ = ls[h]; l_ += __shfl_xor(l_, 16); l_ += __shfl_xor(l_, 32);
                const float inv = 1.0f / l_;
#pragma unroll
                for (int cc = 0; cc < 4; ++cc) { const f32x4 v = o[h][cc] * inv; u32x2 w2; w2.x = pk2(v[0], v[1]); w2.y = pk2(v[2], v[3]);
                    *(u32x2*)(yrow + h * 64 + 16 * cc) = w2;
                    const float a0 = __uint_as_float(w2.x << 16), a1 = __uint_as_float(w2.x & 0xffff0000u), a2 = __uint_as_float(w2.y << 16), a3 = __uint_as_float(w2.y & 0xffff0000u);
                    ss += (a0 * a0 + a1 * a1) + (a2 * a2 + a3 * a3); }
            }
        }
        if (q + 1 < 9) NB_STORE(q + 1);
        __syncthreads();
    }
#undef NB_LOAD
#undef NB_STORE
    ss += __shfl_xor(ss, 16); ss += __shfl_xor(ss, 32);
    const float f = rsqrtf(ss * (1.0f / 384.0f) + 1e-6f);
    asm volatile("s_waitcnt vmcnt(0)" ::: "memory");
    { bf16_t* yb = Y + (size_t)(seqrow + qpos) * 1024 + 4 * 64 + 4 * g;
      u32x2 w3[24];
#pragma unroll
      for (int i = 0; i < 24; ++i) w3[i] = *(const u32x2*)(yb + 16 * i);
#pragma unroll
      for (int i = 0; i < 24; ++i) { u32x2 v = w3[i]; v.x = pk2(__uint_as_float(v.x << 16) * f, __uint_as_float(v.x & 0xffff0000u) * f); v.y = pk2(__uint_as_float(v.y << 16) * f, __uint_as_float(v.y & 0xffff0000u) * f);
          *(u32x2*)(yb + 16 * i) = v; } }
}
}
#include <hip/hip_cooperative_groups.h>
namespace cg = cooperative_groups;
#define LAS __attribute__((address_space(3)))
typedef unsigned short bf16;
typedef unsigned v4u __attribute__((ext_vector_type(4)));
typedef float f32x4 __attribute__((ext_vector_type(4)));

constexpr int DM = 1024, DEPTH = 4, QKVW = 2048, FF = 2816, M_TOK = 49152, M_PROMPT = 16384;
constexpr size_t MiB = 1u << 20;
constexpr size_t WS_CTL = 0;
constexpr size_t WS_TAB = 1 * MiB;
constexpr size_t WS_SSQ = 482 * MiB;
constexpr size_t WS_W = 8 * MiB;
constexpr size_t WS_XB = 98 * MiB;
constexpr size_t WS_QKV = 194 * MiB;
constexpr size_t WS_Y = 386 * MiB;
constexpr size_t WS_H = 194 * MiB;
constexpr size_t WS_END = 490 * MiB;
constexpr size_t W_IN = 0, W_OUT = 2097152, W_GU = 3145728, W_DOWN = 8912896, W_LAYER = 11796480;
#ifndef PG_ALIGN
#define PG_ALIGN true
#endif
#ifndef PG_SP2
#define PG_SP2 true
#endif
constexpr int LDS_BYTES = 147456;
constexpr int MISC_OFF = 147392;
constexpr int BND_OFF = 264192 + 4 * 384;
constexpr int RPB_OFF = 135168;
constexpr int N_LOCAL_ITEMS = 18432;

struct Args { const float* in[12]; float* out; unsigned char* ws; };

__device__ __forceinline__ unsigned f2bf(float f) { unsigned u = __builtin_bit_cast(unsigned, f); return (u + 0x7fffu + ((u >> 16) & 1u)) >> 16; }
__device__ __forceinline__ unsigned pk2h(float lo, float hi) { return f2bf(lo) | (f2bf(hi) << 16); }
__device__ __forceinline__ float wave_sum(float v) {
#pragma unroll
    for (int o = 1; o < 64; o <<= 1) v += __shfl_xor(v, o);
    return v;
}
__device__ __forceinline__ int jrow(int kind, int n) {
    if (kind == 0) {
        const int hd = n >> 6, d = n & 63, pn = hd >> 2, wc = hd & 3;
        const bool typeA = (hd < 4) || (hd == 16) || (hd == 17);
        int fq, bj; if (typeA) { fq = 2 * (d >> 5) + ((d >> 3) & 1); bj = (d >> 4) & 1; } else { fq = (d >> 3) & 3; bj = d >> 5; }
        return 256 * pn + 128 * bj + 32 * wc + 8 * fq + (d & 7);
    } else if (kind == 2) {
        const int bj = n >= FF ? 1 : 0, jh = n - bj * FF;
        return 256 * (jh >> 7) + 128 * bj + (jh & 127);
    }
    return n;
}
__device__ __forceinline__ void transpose_item(const float* W, int K, int N, bf16* WT, int kind, const float* gk, LAS float* scr, int item, int lane) {
    const int nblk = N / 32, kb = item / nblk, nb = item % nblk, k0 = 64 * kb, n0 = 32 * nb;
#pragma unroll 8
    for (int i = 0; i < 32; ++i) { const int kk = 2 * i + (lane >> 5); const float gsc = gk ? gk[k0 + kk] : 1.f; scr[kk * 33 + (lane & 31)] = W[(size_t)(k0 + kk) * N + n0 + (lane & 31)] * gsc; }
    asm volatile("s_waitcnt lgkmcnt(0)" ::: "memory");
    const int c = lane & 7;
#pragma unroll
    for (int j = 0; j < 4; ++j) { const int n = (lane >> 3) + 8 * j; const LAS float* s = scr + (8 * c) * 33 + n;
        v4u o; o.x = pk2h(s[0 * 33], s[1 * 33]); o.y = pk2h(s[2 * 33], s[3 * 33]); o.z = pk2h(s[4 * 33], s[5 * 33]); o.w = pk2h(s[6 * 33], s[7 * 33]);
        *(v4u*)(WT + (size_t)jrow(kind, n0 + n) * K + k0 + 8 * c) = o; }
    asm volatile("s_waitcnt lgkmcnt(0)" ::: "memory");
}

#define XB_TMO      128
#define XB_XCNT(j)  (256  + 64 * (j))
#define XB_XSUB(j)  (1280 + 64 * (j))
#define XB_XGEN(j)  (2304 + 64 * (j))
#define XB_TOP      3328
#define XB_TOPGEN   3392
#define XCD_BAR_WORDS 3456
#define XB_SPIN_CAP (1u << 18)

__device__ __forceinline__ unsigned xb_ld(unsigned* p)              { return __hip_atomic_load(p, __ATOMIC_RELAXED, __HIP_MEMORY_SCOPE_AGENT); }
__device__ __forceinline__ unsigned xb_add(unsigned* p, unsigned v) { return __hip_atomic_fetch_add(p, v, __ATOMIC_RELAXED, __HIP_MEMORY_SCOPE_AGENT); }
__device__ __forceinline__ unsigned xb_xcc_id() { return (unsigned)__builtin_amdgcn_s_getreg((3 << 11) | 20) & 0xFu; }
#define XB_SPIN(cond, bar) do { unsigned _sp = 0; while (cond) { __builtin_amdgcn_s_sleep(1); \
    if ((++_sp & 255u) == 0u) { if (xb_ld(&(bar)[XB_TMO])) break; if (_sp > XB_SPIN_CAP) { atomicAdd(&(bar)[XB_TMO], 1u); break; } } } } while (0)

struct XcdBarrier {
    unsigned* bar; unsigned x;
    volatile LAS unsigned* st;
};

__device__ __forceinline__ XcdBarrier xcd_barrier_post(unsigned* bar, volatile LAS unsigned* st) {
    XcdBarrier b; b.bar = bar; b.x = xb_xcc_id(); b.st = st;
    if (threadIdx.x == 0) (void)xb_add(&bar[XB_XCNT(b.x)], 1u);
    return b;
}
__device__ __forceinline__ void xcd_barrier_complete(unsigned* bar, unsigned x, unsigned& nloc, unsigned& nx) {
    const unsigned G = gridDim.x * gridDim.y * gridDim.z;
    unsigned sum, cnt, mine, sp = 0u;
    for (;;) {
        sum = 0u; cnt = 0u; mine = 0u;
#pragma unroll
        for (unsigned j = 0; j < 16; ++j) { const unsigned c = xb_ld(&bar[XB_XCNT(j)]); sum += c; cnt += (c > 0u) ? 1u : 0u; mine = (j == x) ? c : mine; }
        if (sum == G) break;
        __builtin_amdgcn_s_sleep(1);
        if ((++sp & 255u) == 0u) { if (xb_ld(&bar[XB_TMO])) break; if (sp > XB_SPIN_CAP) { atomicAdd(&bar[XB_TMO], 1u); break; } }
    }
    nloc = mine > 0u ? mine : 1u; nx = cnt > 0u ? cnt : 1u;
}

__device__ __forceinline__ void xcd_barrier(const XcdBarrier& b) {
    asm volatile("s_waitcnt vmcnt(0)" ::: "memory");
    __syncthreads();
    if (threadIdx.x == 0) {
        unsigned* bar = b.bar;
        __builtin_amdgcn_s_waitcnt(0);
        unsigned nloc = b.st[0], nx = b.st[1];
        if (nloc == 0u) { xcd_barrier_complete(bar, b.x, nloc, nx); b.st[0] = nloc; b.st[1] = nx; }
        const unsigned old = xb_add(&bar[XB_XSUB(b.x)], 1u);
        const unsigned gen = old / nloc;
        if (old + 1u == (gen + 1u) * nloc) {
            __builtin_amdgcn_fence(__ATOMIC_RELEASE, "agent");
            asm volatile("s_waitcnt vmcnt(0)" ::: "memory");
            const unsigned og = xb_add(&bar[XB_TOP], 1u);
            const unsigned tg = og / nx;
            if (og + 1u == (tg + 1u) * nx) xb_add(&bar[XB_TOPGEN], 1u);
            else XB_SPIN(xb_ld(&bar[XB_TOPGEN]) == tg, bar);
            __builtin_amdgcn_fence(__ATOMIC_ACQUIRE, "agent");
            xb_add(&bar[XB_XGEN(b.x)], 1u);
            asm volatile("s_waitcnt vmcnt(0)" ::: "memory");
        } else {
            XB_SPIN(xb_ld(&bar[XB_XGEN(b.x)]) == gen, bar);
            __builtin_amdgcn_fence(__ATOMIC_ACQUIRE, "agent");
            asm volatile("s_waitcnt vmcnt(0)" ::: "memory");
        }
    }
    __syncthreads();
}

__global__ void __launch_bounds__(512) fwd_megakernel(Args args) {
    extern __shared__ __attribute__((aligned(16))) unsigned char lds[];
    cg::grid_group grid = cg::this_grid();
    const int tid = threadIdx.x, lane = tid & 63, wave = __builtin_amdgcn_readfirstlane(tid >> 6);
    const int G = gridDim.x, bx = blockIdx.x;
    const int vcu = (G % 8 == 0) ? (bx % 8) * (G / 8) + bx / 8 : bx;
    unsigned char* ws = args.ws;
    const float* x_prompt = args.in[0]; const float* x_sample = args.in[1]; const float* norm_mix = args.in[2]; const float* w_in = args.in[3];
    const float* q_gain = args.in[4]; const float* k_gain = args.in[5]; const float* rpb = args.in[6]; const float* out_gain = args.in[7];
    const float* w_out = args.in[8]; const float* norm_ffn = args.in[9]; const float* w_gate_up = args.in[10]; const float* w_down = args.in[11];
    unsigned* ctl = (unsigned*)(ws + WS_CTL);
    float* cos1 = (float*)(ws + WS_TAB); float* sin1 = cos1 + 4096 * 32; float* cosax = sin1 + 4096 * 32; float* sinax = cosax + 64 * 16;
    typedef unsigned long long u64;
    u64* ssq = (u64*)(ws + WS_SSQ);
    bf16* Wb = (bf16*)(ws + WS_W); bf16* XB = (bf16*)(ws + WS_XB); bf16* QKV = (bf16*)(ws + WS_QKV); bf16* Y = (bf16*)(ws + WS_Y); bf16* H = (bf16*)(ws + WS_H);
    float* out = args.out;
    LAS unsigned char* ldsl = (LAS unsigned char*)lds;
    if (tid < 16) ((LAS unsigned*)(ldsl + MISC_OFF))[tid] = 0u;
    __syncthreads();

#ifndef NO_P0
    {
        const int gw = vcu * 8 + wave, NGW = G * 8, gt = bx * 512 + tid, NGT = G * 512;
        for (int i = gt; i < 8192; i += NGT) ctl[i] = 0u;
        { v4u* z = (v4u*)(ssq + M_TOK); const int nz = 19 * M_TOK / 2; for (int i = gt; i < nz; i += NGT) z[i] = (v4u){0u, 0u, 0u, 0u}; }
        for (int i = gt; i < 4096 * 32 + 64 * 16; i += NGT) {
            int pos, f; float invf;
            if (i < 4096 * 32) { pos = i >> 5; f = i & 31; invf = exp2f(-(float)f * (13.287712379549449f / 32.0f)); }
            else { const int k = i - 4096 * 32; pos = k >> 4; f = k & 15; invf = exp2f(-(float)f * (13.287712379549449f / 16.0f)); }
            const float ang = (float)pos * invf;
            const double rev = (double)ang * 0.15915494309189535; const float fr_ = (float)(rev - __builtin_rint(rev));
            const float cv = __builtin_amdgcn_cosf(fr_), sv = __builtin_amdgcn_sinf(fr_);
            if (i < 4096 * 32) { cos1[i] = cv; sin1[i] = sv; } else { cosax[i - 4096 * 32] = cv; sinax[i - 4096 * 32] = sv; }
        }
        for (int i = gt; i < DEPTH * 384; i += NGT) { const int l_ = i / 384, r_ = i % 384; cos1[264192 + i] = r_ < 192 ? q_gain[l_ * 192 + r_] : k_gain[l_ * 192 + r_ - 192]; }
        if (gw < 12) { const int l_ = gw / 3, mx_ = gw % 3; float a = fabsf(q_gain[l_ * 192 + mx_ * 64 + lane]), b = fabsf(k_gain[l_ * 192 + mx_ * 64 + lane]), c = 0.f;
            if (mx_ == 1) for (int i = lane; i < 6 * 465; i += 64) c = fmaxf(c, fabsf(rpb[(size_t)l_ * 6 * 465 + i]));
#pragma unroll
            for (int o = 1; o < 64; o <<= 1) { a = fmaxf(a, __shfl_xor(a, o)); b = fmaxf(b, __shfl_xor(b, o)); c = fmaxf(c, __shfl_xor(c, o)); }
            if (lane == 0) cos1[BND_OFF + l_ * 4 + mx_] = (8.0f * a * b + c) * 1.4426950408889634f * 1.02f; }
        LAS float* scr = (LAS float*)(ldsl + wave * 16384);
        constexpr int I_IN = 16 * 64, I_OUT = 16 * 32, I_GU = 16 * 176, I_DN = 44 * 32, I_LAYER = I_IN + I_OUT + I_GU + I_DN;
        for (int it = gw; it < DEPTH * I_LAYER; it += NGW) {
            const int l = it / I_LAYER; int r = it % I_LAYER; bf16* Wl = Wb + (size_t)l * W_LAYER;
            if (r < I_IN) { transpose_item(w_in + (size_t)l * DM * QKVW, DM, QKVW, Wl + W_IN, 0, norm_mix + l * DM, scr, r, lane); continue; } r -= I_IN;
            if (r < I_OUT) { transpose_item(w_out + (size_t)l * DM * DM, DM, DM, Wl + W_OUT, 1, out_gain + l * DM, scr, r, lane); continue; } r -= I_OUT;
            if (r < I_GU) { transpose_item(w_gate_up + (size_t)l * DM * 2 * FF, DM, 2 * FF, Wl + W_GU, 2, norm_ffn + l * DM, scr, r, lane); continue; } r -= I_GU;
            transpose_item(w_down + (size_t)l * FF * DM, FF, DM, Wl + W_DOWN, 1, nullptr, scr, r, lane);
        }
        for (int m0 = gw; m0 < M_TOK; m0 += 4 * NGW) {
            f32x4 v[4][4];
#pragma unroll
            for (int r_ = 0; r_ < 4; ++r_) { const int m = m0 + r_ * NGW; if (m < M_TOK) {
                const float* xrow = m < M_PROMPT ? x_prompt + (size_t)m * DM : x_sample + (size_t)(m - M_PROMPT) * DM; const f32x4* xr = (const f32x4*)xrow + lane;
#pragma unroll
                for (int j = 0; j < 4; ++j) v[r_][j] = xr[64 * j]; } }
#pragma unroll
            for (int r_ = 0; r_ < 4; ++r_) { const int m = m0 + r_ * NGW; if (m < M_TOK) {
                float s = 0.f;
#pragma unroll
                for (int j = 0; j < 4; ++j) s += (v[r_][j].x * v[r_][j].x + v[r_][j].y * v[r_][j].y) + (v[r_][j].z * v[r_][j].z + v[r_][j].w * v[r_][j].w);
                s = wave_sum(s);
                unsigned long long* o8 = (unsigned long long*)(XB + (size_t)m * DM) + lane;
#pragma unroll
                for (int j = 0; j < 4; ++j) o8[64 * j] = (unsigned long long)pk2h(v[r_][j].x, v[r_][j].y) | ((unsigned long long)pk2h(v[r_][j].z, v[r_][j].w) << 32);
                if (lane == 0) ssq[m] = (u64)(s * 1073741824.0f); } }
        }
    }
#endif
    grid.sync();
    XcdBarrier xbar = xcd_barrier_post(ctl + 4096, (volatile LAS unsigned*)(ldsl + MISC_OFF));
#define GRID_BAR() xcd_barrier(xbar)

    for (int l = 0; l < DEPTH; ++l) {
        const bf16* Wl = Wb + (size_t)l * W_LAYER;
        int tidl = threadIdx.x; asm volatile("" : "+v"(tidl)); const int lanel = tidl & 63;
        u64* ssq_mix = ssq + (size_t)l * M_TOK; u64* ssq_ffn = ssq + (size_t)(4 + l) * M_TOK;
        u64* ssqA = ssq + (size_t)(8 + l) * M_TOK; u64* ssqB = ssq + (size_t)(12 + l) * M_TOK; u64* ssqC = ssq + (size_t)(16 + l) * M_TOK;
#ifndef NO_P1
        {
            pg8::Gemm g{XB, Wl + W_IN, M_TOK, QKVW, DM}; pg8::StaticOrder S; S.init(M_TOK, QKVW, G, bx);
            pg8::EpiQKV E{QKV, (bf16*)out, ssq_mix, (const float*)(ws + WS_TAB), l, ldsl + 131072};
            pg8::gemm_phase<pg8::EpiQKV, pg8::StaticOrder, PG_ALIGN, PG_SP2>(ldsl, g, S, E);
#ifdef PROBE_P1X2
            __syncthreads();
            pg8::gemm_phase<pg8::EpiQKV, pg8::StaticOrder, PG_ALIGN, PG_SP2>(ldsl, g, S, E);
#endif
        }
#endif
        GRID_BAR();
        {
            LAS float* rpbL = (LAS float*)(ldsl + RPB_OFF);
            const float cA = cos1[BND_OFF + l * 4 + 0], cB = cos1[BND_OFF + l * 4 + 1], cC = cos1[BND_OFF + l * 4 + 2];
            for (int i = tidl; i < 6 * 465; i += 512) rpbL[i] = rpb[(size_t)l * 6 * 465 + i] * 1.4426950408889634f - cB;
            if (tidl == 0) ((volatile LAS unsigned*)(ldsl + MISC_OFF))[4] = 0u;
            __syncthreads();
#ifndef NO_P2A
            const int nA = (G == 256) ? 3 : (768 + G - 1 - vcu) / G;
            for (int ia = 0; ia < nA; ++ia) {
                const int u = (G == 256) ? (ia == 0 ? vcu : 256 + 2 * vcu + (ia - 1)) : vcu + ia * G;
                long rowbase; int T, h, kvh, qb;
                if (u < 256) { const int grp = u >> 5, j = u & 31; kvh = grp & 1; rowbase = (long)(grp >> 1) * 4096; T = 4096; h = 2 * kvh + (j >> 4); qb = j & 15; }
                else { const int su = u - 256, grp = su >> 4, j = su & 15; kvh = grp & 1; rowbase = M_PROMPT + (long)(grp >> 1) * 2048; T = 2048; h = 2 * kvh + (j >> 3); qb = j & 7; }
                attn_body::attn_unit<8>(rowbase, T, h, kvh, qb, (const attn_body::bf16*)QKV, (attn_body::bf16*)Y, ssqA, (char*)lds, cA);
#ifdef PROBE_AX2
                attn_body::attn_unit<8>(rowbase, T, h, kvh, qb, (const attn_body::bf16*)QKV, (attn_body::bf16*)Y, (u64*)XB, (char*)lds, cA);
#endif
            }
#endif
#ifndef NO_P2L
            LAS char* vbuf = (LAS char*)(ldsl + 98304 + wave * loc::VBUF_BYTES);
            {
                const bool bal = (G == 256), lowh = vcu < 128;
                const int nC = bal ? (lowh ? 2 : 1) : (384 + G - 1 - vcu) / G, nB = bal ? (lowh ? 1 : 2) : (384 + G - 1 - vcu) / G;
#ifdef PROBE_LOCAL2
                for (int rep = 0; rep < 2; ++rep)
#endif
                for (int k = 0; k < nC + nB; ++k) {
                    const bool isC = k < nC;
                    int uid;
                    if (isC) uid = bal ? (lowh ? 2 * vcu + k : 256 + (vcu - 128)) : vcu + k * G;
                    else uid = bal ? (lowh ? vcu : 128 + 2 * (vcu - 128) + (k - nC)) : vcu + (k - nC) * G;
                    __syncthreads();
                    int lane_o = lanel; asm volatile("" : "+v"(lane_o));
                    const int g0 = isC ? (uid >> 1) * 256 : uid * 128 + wave * 16;
                    long seqrow; int T; if (g0 < M_PROMPT) { T = 4096; seqrow = g0 & ~4095; } else { T = 2048; seqrow = g0 & ~2047; }
                    if (isC) loc::local_unit<2>(QKV, (const bf16*)out, Y, rpbL, vbuf, seqrow, T, (g0 - (int)seqrow) + 8 * (uid & 1) + wave, lane_o, -cC, (LAS char*)ldsl, wave, (g0 - (int)seqrow) + 8 * (uid & 1) - 64);
                    else loc::local_unit_nb(QKV, (const bf16*)out, Y, rpbL, (LAS char*)ldsl, seqrow, T, ((uid * 128) - (int)seqrow) >> 6, wave, lane_o);
                }
            }
#endif
        }
        GRID_BAR();
#ifndef NO_P3
        {
            const int gw = vcu * 8 + wave, NGW = G * 8;
            for (int m0 = 4 * gw; m0 < M_TOK; m0 += 12 * NGW) {
                v4u a[3], b[3]; float sc[3];
#pragma unroll
                for (int j = 0; j < 3; ++j) { const int m = min(m0 + j * 4 * NGW + (lanel >> 4), M_TOK - 1); const v4u* p = (const v4u*)(Y + (size_t)m * DM + 16 * (lanel & 15)); a[j] = p[0]; b[j] = p[1]; sc[j] = (float)ssqA[m] * (1.0f / 1073741824.0f); }
#pragma unroll
                for (int j = 0; j < 3; ++j) { const int m = m0 + j * 4 * NGW + (lanel >> 4); if (m >= M_TOK) continue; const float f = rsqrtf(sc[j] * (1.0f / 256.0f) + 1e-6f); v4u* p = (v4u*)(Y + (size_t)m * DM + 16 * (lanel & 15));
#pragma unroll
                    for (int e = 0; e < 4; ++e) { a[j][e] = pk2h(__uint_as_float(a[j][e] << 16) * f, __uint_as_float(a[j][e] & 0xffff0000u) * f); b[j][e] = pk2h(__uint_as_float(b[j][e] << 16) * f, __uint_as_float(b[j][e] & 0xffff0000u) * f); }
                    p[0] = a[j]; p[1] = b[j]; }
            }
        }
        GRID_BAR();
        {
            pg8::Gemm g{Y, Wl + W_OUT, M_TOK, DM, DM}; pg8::StaticOrder S; S.init(M_TOK, DM, G, bx);
            pg8::EpiRes2<false> E{XB, out, ssq_ffn};
            pg8::gemm_phase<pg8::EpiRes2<false>, pg8::StaticOrder, PG_ALIGN, PG_SP2>(ldsl, g, S, E);
        }
#endif
        GRID_BAR();
#ifndef NO_P4
        {
            pg8::Gemm g{XB, Wl + W_GU, M_TOK, 2 * FF, DM}; pg8::StaticOrder S; S.init(M_TOK, 2 * FF, G, bx);
            pg8::EpiGU E{H, ssq_ffn, ldsl + 131072};
            pg8::gemm_phase<pg8::EpiGU, pg8::StaticOrder, PG_ALIGN, PG_SP2>(ldsl, g, S, E);
#ifdef PROBE_P4X2
            __syncthreads();
            pg8::gemm_phase<pg8::EpiGU, pg8::StaticOrder, PG_ALIGN, PG_SP2>(ldsl, g, S, E);
#endif
        }
#endif
        GRID_BAR();
#ifndef NO_P5
        {
            pg8::Gemm g{H, Wl + W_DOWN, M_TOK, DM, FF}; pg8::StaticOrder S; S.init(M_TOK, DM, G, bx);
            if (l + 1 < DEPTH) { pg8::EpiRes2<false> E{XB, out, ssq + (size_t)(l + 1) * M_TOK}; pg8::gemm_phase<pg8::EpiRes2<false>, pg8::StaticOrder, PG_ALIGN, PG_SP2>(ldsl, g, S, E); }
            else { pg8::EpiRes2<true> E{XB, out, nullptr}; pg8::gemm_phase<pg8::EpiRes2<true>, pg8::StaticOrder, PG_ALIGN, PG_SP2>(ldsl, g, S, E); }
        }
#endif
        if (l + 1 < DEPTH) GRID_BAR();
    }
}

extern "C" void kernel_launch(void* const* d_in, const int* in_sizes, int n_in, void* d_out, int out_size, void* d_ws, size_t ws_size, hipStream_t stream) {
    static int grid_blocks = 0;
    if (grid_blocks == 0) {
        if (n_in != 12 || out_size != M_TOK * DM || ws_size < WS_END) { fprintf(stderr, "kernel_launch: unexpected shapes (n_in %d out %d ws %zu)\n", n_in, out_size, ws_size); grid_blocks = -1; return; }
        int dev = 0, cus = 0, per_cu = 0;
        hipGetDevice(&dev); hipDeviceGetAttribute(&cus, hipDeviceAttributeMultiprocessorCount, dev);
        hipFuncSetAttribute((const void*)fwd_megakernel, hipFuncAttributeMaxDynamicSharedMemorySize, LDS_BYTES);
        hipOccupancyMaxActiveBlocksPerMultiprocessor(&per_cu, (const void*)fwd_megakernel, 512, LDS_BYTES);
        if (per_cu < 1) { fprintf(stderr, "kernel_launch: occupancy query says %d blocks per CU\n", per_cu); per_cu = 1; }
        grid_blocks = cus * 1;
    }
    if (grid_blocks < 0) return;
    Args a{};
    for (int i = 0; i < 12; ++i) a.in[i] = (const float*)d_in[i];
    a.out = (float*)d_out; a.ws = (unsigned char*)d_ws;
    void* kargs[] = {&a};
    hipError_t e = hipLaunchCooperativeKernel((const void*)fwd_megakernel, dim3(grid_blocks), dim3(512), kargs, LDS_BYTES, stream);
    if (e != hipSuccess) fprintf(stderr, "cooperative launch failed: %s (grid %d)\n", hipGetErrorString(e), grid_blocks);
}
```

```cpp
#include <hip/hip_runtime.h>
#include <cstdio>
#include <cstdint>
namespace pg8 {
#define PG8_LAS __attribute__((address_space(3)))
typedef unsigned short bf16_t;
typedef short bf16x8 __attribute__((ext_vector_type(8)));
typedef float f32x4 __attribute__((ext_vector_type(4)));
typedef unsigned u32x4 __attribute__((ext_vector_type(4)));
constexpr int BM = 256, BK = 64, HALF = 128, HTB = HALF * BK * 2  , STAGE_BYTES = 8 * HTB, NXCD = 8, WGM = 4;

__host__ __device__ __forceinline__ int lds_byte(int r, int c) { const int st = (r >> 4) * 2 + (c >> 5), rr = r & 15, cc = c & 31, ob = rr * 64 + cc * 2; return st * 1024 + (ob ^ (((ob >> 9) & 1) << 5)); }
__host__ __device__ __forceinline__ void stage_rc(int b, int& R, int& C) { const int st = b / 1024, sb = b % 1024, swz = sb ^ (((sb >> 9) & 1) << 5); R = (st >> 1) * 16 + swz / 64; C = (st & 1) * 32 + (swz % 64) / 2; }
__host__ __device__ __forceinline__ int perm32(int rho) { const int n = rho >> 4, i = rho & 15; return 8 * (i >> 2) + 4 * n + (i & 3); }

struct Unit { int pm, pn; };
struct Gemm { const bf16_t* A; const bf16_t* Bt; int M, N, K; };

struct StaticOrder {
    int nM, nN, nwg, G, c;
    __host__ __device__ void init(int M, int N, int G_, int c_) { nM = M / BM; nN = N / BM; nwg = nM * nN; G = G_; c = c_; }
    __host__ __device__ bool next(int i, Unit& u) const {
        const long L = (long)i * G + c; if (L >= nwg) return false;
        int wgid = (int)L; { const int q = nwg / NXCD, r = nwg % NXCD, xcd = wgid % NXCD, off = wgid / NXCD; wgid = (xcd < r ? xcd * (q + 1) : r * (q + 1) + (xcd - r) * q) + off; }
        const int nig = WGM * nN, gid = wgid / nig, fm = gid * WGM, gsz = (nM - fm) < WGM ? (nM - fm) : WGM;
        u.pm = fm + ((wgid % nig) % gsz); u.pn = (wgid % nig) / gsz; return true;
    }
    __device__ __forceinline__ void a_ready(const Unit&) const {}
    __device__ __forceinline__ void done(const Unit&) const {}
};

__device__ __forceinline__ unsigned cvt_pk_bf16(float lo, float hi) { unsigned r; asm volatile("v_cvt_pk_bf16_f32 %0, %1, %2" : "=v"(r) : "v"(lo), "v"(hi)); return r; }
typedef float f32x2 __attribute__((ext_vector_type(2)));
constexpr float RMS_EPS = 1e-6f;
typedef unsigned long long u64;
__device__ __forceinline__ void ssq_add(u64* p, float v) { atomicAdd(p, (u64)(v * 1073741824.0f)); }
__device__ __forceinline__ float ssq_get(const u64* p) { return (float)(*p) * (1.0f / 1073741824.0f); }
constexpr float QSCALE = 0.125f * 1.4426950408889634f;
__device__ __forceinline__ int seq_pos(int row) { return row < 16384 ? (row & 4095) : (row & 2047); }
__device__ __forceinline__ u32x4 pack8(const f32x4 a, const f32x4 b) { u32x4 w; w.x = cvt_pk_bf16(a[0], a[1]); w.y = cvt_pk_bf16(a[2], a[3]); w.z = cvt_pk_bf16(b[0], b[1]); w.w = cvt_pk_bf16(b[2], b[3]); return w; }

struct EpiQKV {
    static constexpr bool PERM = true, AFTER_DRAIN = false, KHOOK = false, SSQ_LDS = true;
    bf16_t* QKV; bf16_t* KVC; const u64* ssq; const float* tab; int layer; PG8_LAS unsigned char* stab;
    __device__ __forceinline__ void prefetch(const Unit& u, int ui, int wid, int lane) const {
        __builtin_amdgcn_global_load_lds((const unsigned*)(ssq + (size_t)u.pm * BM) + wid * 64 + lane, (PG8_LAS unsigned*)(stab + (ui & 1) * 2048 + wid * 256), 4, 0, 0); }
    __device__ __forceinline__ void epi(const f32x4 (&acc)[2][2][4][2], const Unit& u, int wr, int wc, int fr, int fq, int ui) const {
        const int hd = u.pn * 4 + wc;
        int kind, mixer;
        if (hd < 16) { kind = 0; mixer = hd < 4 ? 0 : (hd < 10 ? 1 : 2); }
        else if (hd < 24) { kind = 1; const int kh = hd - 16; mixer = kh < 2 ? 0 : (kh < 5 ? 1 : 2); }
        else { kind = 2; mixer = 1; }
        const bool typeA = (kind != 2) && (mixer == 0);
        const int db0 = typeA ? (32 * (fq >> 1) + 8 * (fq & 1)) : 8 * fq;
        const int dstep = typeA ? 16 : 32;
        const float* cos1 = tab; const float* sin1 = tab + 131072; const float* cosax = tab + 262144; const float* sinax = tab + 263168;
        const float* gp = tab + 264192 + layer * 384 + (kind == 1 ? 192 : 0) + mixer * 64 + db0;
        const float qs = (kind == 0) ? QSCALE : 1.f;
        const bool rope = (kind != 2) && (mixer != 1);
        const int row0 = u.pm * BM + wr * 64 + fr;
        float rr[8];
#pragma unroll
        for (int i = 0; i < 8; ++i) rr[i] = (float)(*(const PG8_LAS u64*)(stab + (ui & 1) * 2048 + (wr * 64 + fr + (i >> 2) * HALF + (i & 3) * 16) * 8)) * (1.0f / 1073741824.0f);
        f32x4 gn[2][2];
#pragma unroll
        for (int bj = 0; bj < 2; ++bj)
#pragma unroll
            for (int n = 0; n < 2; ++n) gn[bj][n] = (kind != 2) ? *(const f32x4*)(gp + bj * dstep + 4 * n) : (f32x4){1.f, 1.f, 1.f, 1.f};
        f32x4 cn[2], sn[2];
#define QKV_TAB(i_) do { if (rope) { const int t_ = seq_pos(row0 + ((i_) >> 2) * HALF + ((i_) & 3) * 16); const float* cp_; const float* sp_; \
            if (mixer == 0) { const int pos_ = (fq >> 1) ? (t_ & 63) : (t_ >> 6); cp_ = cosax + pos_ * 16 + 8 * (fq & 1); sp_ = sinax + pos_ * 16 + 8 * (fq & 1); } \
            else { cp_ = cos1 + t_ * 32 + 8 * fq; sp_ = sin1 + t_ * 32 + 8 * fq; } \
            cn[0] = *(const f32x4*)cp_; cn[1] = *(const f32x4*)(cp_ + 4); sn[0] = *(const f32x4*)sp_; sn[1] = *(const f32x4*)(sp_ + 4); } } while (0)
        QKV_TAB(0);
#pragma unroll
        for (int i = 0; i < 8; ++i) {
            const int ai = i >> 2, m = i & 3;
            const int row = row0 + ai * HALF + m * 16;
            const f32x4 c0 = cn[0], c1 = cn[1], s0 = sn[0], s1 = sn[1];
            if (i + 1 < 8) QKV_TAB(i + 1);
            const float r = rsqrtf(rr[i] * (1.0f / 1024.0f) + RMS_EPS);
            f32x4 v[2][2];
#pragma unroll
            for (int bj = 0; bj < 2; ++bj)
#pragma unroll
                for (int n = 0; n < 2; ++n) v[bj][n] = acc[ai][bj][m][n] * r;
            if (kind != 2) {
                float ss = 0.f;
#pragma unroll
                for (int bj = 0; bj < 2; ++bj)
#pragma unroll
                    for (int n = 0; n < 2; ++n) { const f32x4 x = v[bj][n]; ss += (x[0] * x[0] + x[1] * x[1]) + (x[2] * x[2] + x[3] * x[3]); }
                ss += __shfl_xor(ss, 16); ss += __shfl_xor(ss, 32);
                const float rn = rsqrtf(ss * (1.0f / 64.0f) + RMS_EPS);
#pragma unroll
                for (int bj = 0; bj < 2; ++bj)
#pragma unroll
                    for (int n = 0; n < 2; ++n) v[bj][n] = v[bj][n] * rn * gn[bj][n];
                if (rope) {
                    { const f32x4 x1 = v[0][0], x2 = v[1][0]; v[0][0] = x1 * c0 - x2 * s0; v[1][0] = x2 * c0 + x1 * s0; }
                    { const f32x4 x1 = v[0][1], x2 = v[1][1]; v[0][1] = x1 * c1 - x2 * s1; v[1][1] = x2 * c1 + x1 * s1; }
                }
#pragma unroll
                for (int bj = 0; bj < 2; ++bj)
#pragma unroll
                    for (int n = 0; n < 2; ++n) v[bj][n] = v[bj][n] * qs;
            }
            bf16_t* rowp = QKV + (size_t)row * 2048 + hd * 64 + db0;
            if (hd >= 18 && hd < 24) rowp = KVC + ((size_t)(hd - 18) * 49152 + row) * 128 + db0;
            else if (hd >= 26) rowp = KVC + ((size_t)(hd - 26) * 49152 + row) * 128 + 64 + db0;
#pragma unroll
            for (int bj = 0; bj < 2; ++bj) *(u32x4*)(rowp + bj * dstep) = pack8(v[bj][0], v[bj][1]);
            asm volatile("" ::: "memory");
        }
#undef QKV_TAB
    }
};

struct EpiGU {
    static constexpr bool PERM = true, AFTER_DRAIN = false, KHOOK = false, SSQ_LDS = true;
    bf16_t* H; const u64* ssq; PG8_LAS unsigned char* stab;
    __device__ __forceinline__ void prefetch(const Unit& u, int ui, int wid, int lane) const {
        __builtin_amdgcn_global_load_lds((const unsigned*)(ssq + (size_t)u.pm * BM) + wid * 64 + lane, (PG8_LAS unsigned*)(stab + (ui & 1) * 2048 + wid * 256), 4, 0, 0); }
    __device__ __forceinline__ void epi(const f32x4 (&acc)[2][2][4][2], const Unit& u, int wr, int wc, int fr, int fq, int ui) const {
        const int col0 = u.pn * HALF + wc * 32 + 8 * fq;
#pragma unroll
        for (int ai = 0; ai < 2; ++ai)
#pragma unroll
            for (int m = 0; m < 4; ++m) {
                const int row = u.pm * BM + ai * HALF + wr * 64 + m * 16 + fr;
                const float r = rsqrtf((float)(*(const PG8_LAS u64*)(stab + (ui & 1) * 2048 + (ai * HALF + wr * 64 + m * 16 + fr) * 8)) * (1.0f / 1073741824.0f) * (1.0f / 1024.0f) + RMS_EPS);
                f32x4 h[2];
#pragma unroll
                for (int n = 0; n < 2; ++n) {
                    const f32x4 g = acc[ai][0][m][n] * r, uu = acc[ai][1][m][n] * r;
#pragma unroll
                    for (int e = 0; e < 4; ++e) { const float sg = __builtin_amdgcn_rcpf(1.0f + __builtin_amdgcn_exp2f(-1.4426950408889634f * g[e])); h[n][e] = g[e] * sg * uu[e]; }
                }
                __builtin_nontemporal_store(pack8(h[0], h[1]), (u32x4*)(H + (size_t)row * 2816 + col0));
            }
    }
};

template <bool LAST> struct EpiRes2 {
    static constexpr bool PERM = true, AFTER_DRAIN = false, KHOOK = false, SSQ_LDS = false;
    bf16_t* XB; float* out; u64* ssq_next;
    __device__ __forceinline__ void operator()(const f32x4 (&acc)[2][2][4][2], const Unit& u, int wr, int wc, int fr, int fq) const {
        const int col0 = u.pn * BM + wc * 32 + 8 * fq;
        const int row0 = u.pm * BM + wr * 64 + fr;
        u32x4 w[8][2];
#pragma unroll
        for (int i = 0; i < 8; ++i)
#pragma unroll
            for (int bj = 0; bj < 2; ++bj) w[i][bj] = *(const u32x4*)(XB + (size_t)(row0 + (i >> 2) * HALF + (i & 3) * 16) * 1024 + col0 + bj * HALF);
#pragma unroll
        for (int i = 0; i < 8; ++i) {
            const int ai = i >> 2, m = i & 3;
            const int row = row0 + ai * HALF + m * 16;
            float ss = 0.f;
#pragma unroll
            for (int bj = 0; bj < 2; ++bj) {
                f32x4 x[2];
#pragma unroll
                for (int n = 0; n < 2; ++n) { const unsigned lo = w[i][bj][2 * n], hi = w[i][bj][2 * n + 1];
                    const f32x4 bs = (f32x4){__uint_as_float(lo << 16), __uint_as_float(lo & 0xffff0000u), __uint_as_float(hi << 16), __uint_as_float(hi & 0xffff0000u)};
                    x[n] = bs + acc[ai][bj][m][n]; ss += (x[n][0] * x[n][0] + x[n][1] * x[n][1]) + (x[n][2] * x[n][2] + x[n][3] * x[n][3]); }
                if (LAST) { float* op = out + (size_t)row * 1024 + col0 + bj * HALF; *(f32x4*)op = x[0]; *(f32x4*)(op + 4) = x[1]; }
                else *(u32x4*)(XB + (size_t)row * 1024 + col0 + bj * HALF) = pack8(x[0], x[1]);
            }
            if (!LAST) { ss += __shfl_xor(ss, 16); ss += __shfl_xor(ss, 32); if (fq == 0) ssq_add(ssq_next + row, ss); }
        }
    }
};
template <class Epi, class Sched, bool ALIGN_EPI = false, bool SP2 = false>
__device__ __forceinline__ void gemm_phase(PG8_LAS unsigned char* lds, const Gemm g, const Sched& S, const Epi& E) {
    int tid_ = threadIdx.x; asm volatile("" : "+v"(tid_));
    const int tid = tid_, wid = __builtin_amdgcn_readfirstlane(tid >> 6), lane = tid & 63, wr = wid >> 2, wc = wid & 3, fr = lane & 15, fq = lane >> 4;
    const int K = g.K, nt = K / BK;
    unsigned voffA[2], voffB[2];
#pragma unroll
    for (int i = 0; i < 2; ++i) { int R, C; stage_rc(tid * 16 + i * 8192, R, C); const int Rb = Epi::PERM ? ((R & ~31) + perm32(R & 31)) : R;
        voffA[i] = (unsigned)(R * K + C) * 2u; voffB[i] = (unsigned)(Rb * K + C) * 2u; }
    const size_t kstep = (size_t)(BK * 2);
    const size_t hstep = (size_t)HALF * K * 2;
    const size_t tstep = 2 * hstep;
    const unsigned ldsw = (unsigned)wid * 1024u;
    const int aoff = lds_byte(wr * 64 + fr, fq * 8), boff = lds_byte(wc * 32 + fr, fq * 8);
#define PG8_SA(b, h) (((b) * 2 + (h)) * HTB)
#define PG8_SB(b, h) ((4 + (b) * 2 + (h)) * HTB)
#define PG8_STAGE(bufoff, gbase, voff) do { _Pragma("unroll") for (int _i = 0; _i < 2; ++_i) \
        __builtin_amdgcn_global_load_lds((const unsigned*)((const char*)(gbase) + (voff)[_i]), (PG8_LAS unsigned*)(lds + (bufoff) + ldsw + _i * 8192), 16, 0, 0); } while (0)
#define PG8_LDA(dst, b, h) do { _Pragma("unroll") for (int m = 0; m < 4; ++m) _Pragma("unroll") for (int k = 0; k < 2; ++k) dst[m][k] = *(const PG8_LAS bf16x8*)(lds + PG8_SA(b, h) + aoff + m * 2048 + k * 1024); } while (0)
#define PG8_LDB(dst, b, h) do { _Pragma("unroll") for (int n = 0; n < 2; ++n) _Pragma("unroll") for (int k = 0; k < 2; ++k) dst[n][k] = *(const PG8_LAS bf16x8*)(lds + PG8_SB(b, h) + boff + n * 2048 + k * 1024); } while (0)
#define PG8_MMA(ai, bj, At, Bt) do { __builtin_amdgcn_s_setprio(1); _Pragma("unroll") for (int m = 0; m < 4; ++m) _Pragma("unroll") for (int n = 0; n < 2; ++n) _Pragma("unroll") for (int k = 0; k < 2; ++k) \
        acc[ai][bj][m][n] = __builtin_amdgcn_mfma_f32_16x16x32_bf16(Bt[n][k], At[m][k], acc[ai][bj][m][n], 0, 0, 0); __builtin_amdgcn_s_setprio(0); } while (0)
#define PG8_WAIT_V(n) asm volatile("s_waitcnt vmcnt(" #n ")" ::: "memory")
#define PG8_WAIT_L(n) asm volatile("s_waitcnt lgkmcnt(" #n ")" ::: "memory")
#define PG8_BAR __builtin_amdgcn_s_barrier()
#define PG8_SCHED __builtin_amdgcn_sched_barrier(0)
    Unit cur, nxt; int ui = 0;
    if (!S.next(0, cur)) return;
    f32x4 acc[2][2][4][2];
#pragma unroll
    for (int a = 0; a < 2; ++a)
#pragma unroll
        for (int b = 0; b < 2; ++b)
#pragma unroll
            for (int m = 0; m < 4; ++m)
#pragma unroll
                for (int n = 0; n < 2; ++n) acc[a][b][m][n] = (f32x4){0.f, 0.f, 0.f, 0.f};
    bf16x8 At[4][2], B0[2][2], B1[2][2];
    const char* cA = (const char*)g.A + (size_t)cur.pm * tstep; const char* cB = (const char*)g.Bt + (size_t)cur.pn * tstep;
    S.a_ready(cur);
    if constexpr (SP2) {
        PG8_STAGE(PG8_SB(0, 0), cB, voffB); PG8_STAGE(PG8_SB(0, 1), cB + hstep, voffB); PG8_STAGE(PG8_SA(0, 0), cA, voffA); PG8_STAGE(PG8_SA(0, 1), cA + hstep, voffA);
        if (wr == 1) PG8_BAR;
        PG8_WAIT_V(2); PG8_BAR;
        PG8_STAGE(PG8_SB(1, 0), cB + kstep, voffB); PG8_STAGE(PG8_SA(1, 0), cA + kstep, voffA); PG8_STAGE(PG8_SB(1, 1), cB + hstep + kstep, voffB);
        PG8_WAIT_V(6); PG8_BAR;
    } else {
        PG8_STAGE(PG8_SB(0, 0), cB, voffB); PG8_STAGE(PG8_SA(0, 0), cA, voffA); PG8_STAGE(PG8_SB(0, 1), cB + hstep, voffB); PG8_STAGE(PG8_SA(0, 1), cA + hstep, voffA);
        if (wr == 1) PG8_BAR;
        PG8_WAIT_V(4); PG8_BAR;
        PG8_STAGE(PG8_SB(1, 0), cB + kstep, voffB); PG8_STAGE(PG8_SA(1, 0), cA + kstep, voffA); PG8_STAGE(PG8_SB(1, 1), cB + hstep + kstep, voffB);
        PG8_WAIT_V(6); PG8_BAR;
    }
    for (;;) {
        const bool has_next = S.next(ui + 1, nxt);
        if constexpr (Epi::SSQ_LDS) E.prefetch(cur, ui, wid, lane);
        const char* nA = has_next ? (const char*)g.A + (size_t)nxt.pm * tstep : cA; const char* nB = has_next ? (const char*)g.Bt + (size_t)nxt.pn * tstep : cB;
        for (int t = 0; t < nt; t += 2) {
            const bool last = (t == nt - 2);
            if constexpr (Epi::KHOOK) { if (t == 4 || t == 10) { PG8_SCHED; asm volatile("" ::: "memory"); E.khook(acc, cur, wr, fr, t == 4 ? 0 : 1); asm volatile("" ::: "memory"); PG8_SCHED; } }
            const char* a1 = cA + (size_t)(t + 1) * kstep;
            const char* a2 = last ? nA : cA + (size_t)(t + 2) * kstep; const char* b2 = last ? nB : cB + (size_t)(t + 2) * kstep;
            const char* a3 = a2 + kstep; const char* b3 = b2 + kstep;
            if (last && has_next) S.a_ready(nxt);
            if constexpr (SP2) {
            PG8_LDB(B0, 0, 0); PG8_LDB(B1, 0, 1); PG8_SCHED; PG8_LDA(At, 0, 0); PG8_STAGE(PG8_SA(1, 1), a1 + hstep, voffA);
            PG8_WAIT_V(8); PG8_WAIT_L(0); PG8_BAR; PG8_MMA(0, 0, At, B0); PG8_MMA(0, 1, At, B1); PG8_BAR; PG8_SCHED;
            PG8_LDA(At, 0, 1); PG8_STAGE(PG8_SB(0, 0), b2, voffB); PG8_STAGE(PG8_SB(0, 1), b2 + hstep, voffB); PG8_STAGE(PG8_SA(0, 0), a2, voffA);
            PG8_WAIT_V(8); PG8_WAIT_L(0); PG8_BAR; PG8_MMA(1, 0, At, B0); PG8_MMA(1, 1, At, B1); PG8_BAR; PG8_SCHED;
            PG8_LDB(B0, 1, 0); PG8_LDB(B1, 1, 1); PG8_SCHED; PG8_LDA(At, 1, 0); PG8_STAGE(PG8_SA(0, 1), a2 + hstep, voffA);
            PG8_WAIT_V(8); PG8_WAIT_L(0); PG8_BAR; PG8_MMA(0, 0, At, B0); PG8_MMA(0, 1, At, B1); PG8_BAR; PG8_SCHED;
            PG8_LDA(At, 1, 1); PG8_STAGE(PG8_SB(1, 0), b3, voffB); PG8_STAGE(PG8_SB(1, 1), b3 + hstep, voffB); PG8_STAGE(PG8_SA(1, 0), a3, voffA);
            PG8_WAIT_V(8); PG8_WAIT_L(0); PG8_BAR; PG8_MMA(1, 0, At, B0); PG8_MMA(1, 1, At, B1); PG8_BAR; PG8_SCHED;
            } else {
            PG8_LDB(B0, 0, 0); PG8_SCHED; PG8_LDA(At, 0, 0); PG8_STAGE(PG8_SA(1, 1), a1 + hstep, voffA);
            PG8_WAIT_L(8); PG8_BAR; PG8_WAIT_L(0); PG8_MMA(0, 0, At, B0); PG8_BAR; PG8_SCHED;
            PG8_LDB(B1, 0, 1); PG8_STAGE(PG8_SB(0, 0), b2, voffB);
            PG8_BAR; PG8_WAIT_L(0); PG8_MMA(0, 1, At, B1); PG8_BAR;
            PG8_LDA(At, 0, 1); PG8_STAGE(PG8_SA(0, 0), a2, voffA);
            PG8_BAR; PG8_WAIT_L(0); PG8_MMA(1, 0, At, B0); PG8_BAR; PG8_SCHED;
            PG8_STAGE(PG8_SB(0, 1), b2 + hstep, voffB);
            PG8_WAIT_V(6); PG8_BAR; PG8_MMA(1, 1, At, B1); PG8_BAR;
            PG8_LDB(B0, 1, 0); PG8_SCHED; PG8_LDA(At, 1, 0); PG8_STAGE(PG8_SA(0, 1), a2 + hstep, voffA);
            PG8_WAIT_L(8); PG8_BAR; PG8_WAIT_L(0); PG8_MMA(0, 0, At, B0); PG8_BAR; PG8_SCHED;
            PG8_LDB(B1, 1, 1); PG8_STAGE(PG8_SB(1, 0), b3, voffB);
            PG8_BAR; PG8_WAIT_L(0); PG8_MMA(0, 1, At, B1); PG8_BAR;
            PG8_LDA(At, 1, 1); PG8_STAGE(PG8_SA(1, 0), a3, voffA);
            PG8_BAR; PG8_WAIT_L(0); PG8_MMA(1, 0, At, B0); PG8_BAR; PG8_SCHED;
            PG8_STAGE(PG8_SB(1, 1), b3 + hstep, voffB);
            PG8_WAIT_V(6); PG8_BAR; PG8_MMA(1, 1, At, B1); PG8_BAR;
            }
        }
        if constexpr (ALIGN_EPI) { if (wr == 0) PG8_BAR; }
        if constexpr (!Epi::AFTER_DRAIN) { if constexpr (Epi::SSQ_LDS) E.epi(acc, cur, wr, wc, fr, fq, ui); else E(acc, cur, wr, wc, fr, fq); S.done(cur); }
        if (!has_next) break;
#pragma unroll
        for (int a = 0; a < 2; ++a)
#pragma unroll
            for (int b = 0; b < 2; ++b)
#pragma unroll
                for (int m = 0; m < 4; ++m)
#pragma unroll
                    for (int n = 0; n < 2; ++n) acc[a][b][m][n] = (f32x4){0.f, 0.f, 0.f, 0.f};
        cur = nxt; cA = nA; cB = nB; ++ui;
        if constexpr (ALIGN_EPI) { if (wr == 1) PG8_BAR; }
    }
    PG8_WAIT_V(0);
    if constexpr (!ALIGN_EPI) { if (wr == 0) PG8_BAR; }
    PG8_BAR;
    if constexpr (Epi::AFTER_DRAIN) { E.fused(acc, cur, wr, wc, fr, fq, lds, wid, lane); S.done(cur); }
#undef PG8_SA
#undef PG8_SB
#undef PG8_STAGE
#undef PG8_LDA
#undef PG8_LDB
#undef PG8_MMA
#undef PG8_WAIT_V
#undef PG8_WAIT_L
#undef PG8_BAR
#undef PG8_SCHED
}
}
#include <hip/hip_bf16.h>
#include <cmath>
namespace attn_body {
using bf16=__hip_bfloat16;
using bf16x8=__attribute__((ext_vector_type(8)))short;
using s16x4=__attribute__((ext_vector_type(4)))short;
using f32x16=__attribute__((ext_vector_type(16)))float;
using u32x4=__attribute__((ext_vector_type(4)))unsigned;
constexpr int D=64,QP=2048,OP=1024;
constexpr int NW=8,QBLK=32,QB=QBLK*NW,KVBLK=64;

__device__ __forceinline__ int crow(int r,int hi){return (r&3)+8*(r>>2)+4*hi;}
#define SBAR() __builtin_amdgcn_sched_barrier(0)
__device__ __forceinline__ void cmask(f32x16&p0,f32x16&p1,int jb,int qrel,int hi){
  const float NEG=-INFINITY; int kb=64*jb+4*hi;
  #pragma unroll
  for(int r=0;r<16;++r){int kv=kb+(r&3)+8*(r>>2); if(kv>qrel)p0[r]=NEG; if(kv+32>qrel)p1[r]=NEG;}
}

constexpr int NSLOT=3, SLOTB=8192;
constexpr int LDS_K=0, LDS_V=NSLOT*SLOTB, LDS_WS=2*NSLOT*SLOTB, LDS_OST=LDS_WS+NW*64*4, LDS_BYTES=LDS_OST+NW*4096;
constexpr float C2=0.125f*1.4426950408889634f;
__device__ __forceinline__ void glds16(const void*gsrc,unsigned lds_dst){unsigned keep;
  asm volatile("s_mov_b32 %0, m0\n\ts_mov_b32 m0, %2\n\ts_nop 0\n\tglobal_load_lds_dwordx4 %1, off\n\ts_mov_b32 m0, %0":"=&s"(keep):"v"(gsrc),"s"(lds_dst):"memory");}
__device__ __forceinline__ float max3f(float a,float b,float c){float r;asm("v_max3_f32 %0, %1, %2, %3":"=v"(r):"v"(a),"v"(b),"v"(c));return r;}
__device__ __forceinline__ float max2f(float a,float b){float r;asm("v_max_f32_e32 %0, %1, %2":"=v"(r):"v"(a),"v"(b));return r;}
__device__ __forceinline__ float fadd_s(float a,float b){float r;asm("v_add_f32_e32 %0, %1, %2":"=v"(r):"v"(a),"v"(b));return r;}
__device__ __forceinline__ float fsub_s(float a,float b){float r;asm("v_sub_f32_e32 %0, %1, %2":"=v"(r):"v"(a),"v"(b));return r;}
typedef float f32x2_t __attribute__((ext_vector_type(2))); typedef __bf16 bf16x2_t __attribute__((ext_vector_type(2)));
__device__ __forceinline__ unsigned cvtpk_s(float lo,float hi){f32x2_t v={lo,hi};bf16x2_t b=__builtin_convertvector(v,bf16x2_t);return __builtin_bit_cast(unsigned,b);}
#define WAIT_BAR(N) asm volatile("s_waitcnt vmcnt(" #N ") lgkmcnt(0)\n\ts_barrier":::"memory")

__device__ __forceinline__ void qkt(f32x16&p0,f32x16&p1,const char*Kslot,const bf16x8*qr,const f32x16&negm,int r32,int hi){
  const char*kb=Kslot+hi*1024+r32*16;
  #pragma unroll
  for(int d0=0;d0<4;++d0){
    const bf16x8 b0=*reinterpret_cast<const bf16x8*>(kb+d0*2048);
    const bf16x8 b1=*reinterpret_cast<const bf16x8*>(kb+d0*2048+512);
    if(d0==0){p0=__builtin_amdgcn_mfma_f32_32x32x16_bf16(b0,qr[0],negm,0,0,0);p1=__builtin_amdgcn_mfma_f32_32x32x16_bf16(b1,qr[0],negm,0,0,0);}
    else{p0=__builtin_amdgcn_mfma_f32_32x32x16_bf16(b0,qr[d0],p0,0,0,0);p1=__builtin_amdgcn_mfma_f32_32x32x16_bf16(b1,qr[d0],p1,0,0,0);}}
}
typedef __attribute__((address_space(3))) const char* lds_cptr;
typedef short v4i16_t __attribute__((ext_vector_type(4)));
__device__ __forceinline__ void kload8(bf16x8*kf,lds_cptr kp){
  kf[0]=*(const __attribute__((address_space(3))) bf16x8*)(kp);      kf[1]=*(const __attribute__((address_space(3))) bf16x8*)(kp+512);
  kf[2]=*(const __attribute__((address_space(3))) bf16x8*)(kp+2048); kf[3]=*(const __attribute__((address_space(3))) bf16x8*)(kp+2560);
  kf[4]=*(const __attribute__((address_space(3))) bf16x8*)(kp+4096); kf[5]=*(const __attribute__((address_space(3))) bf16x8*)(kp+4608);
  kf[6]=*(const __attribute__((address_space(3))) bf16x8*)(kp+6144); kf[7]=*(const __attribute__((address_space(3))) bf16x8*)(kp+6656);
}
__device__ __forceinline__ void kload2(bf16x8*kf,lds_cptr kp,int j){ kf[2*j]=*(const __attribute__((address_space(3))) bf16x8*)(kp+j*2048); kf[2*j+1]=*(const __attribute__((address_space(3))) bf16x8*)(kp+j*2048+512); }
__device__ __forceinline__ s16x4 vtr(lds_cptr p){ return __builtin_bit_cast(s16x4,__builtin_amdgcn_ds_read_tr16_b64_v4i16((__attribute__((address_space(3))) v4i16_t*)p)); }
__device__ __forceinline__ float rowmax(const f32x16&p0,const f32x16&p1){
  float a=max3f(p0[0],p0[1],p1[0]),b=max3f(p0[2],p0[3],p1[1]);a=max3f(a,p1[2],p1[3]);
  #pragma unroll
  for(int r=4;r<16;r+=4){a=max3f(a,p0[r],p0[r+1]);b=max3f(b,p0[r+2],p0[r+3]);a=max3f(a,p1[r],p1[r+1]);b=max3f(b,p1[r+2],p1[r+3]);}
  const float m=max2f(a,b);
  auto rr=__builtin_amdgcn_permlane32_swap(__float_as_uint(m),__float_as_uint(m),false,false);
  return max2f(__uint_as_float(rr[0]),__uint_as_float(rr[1]));
}
__device__ __forceinline__ void pv(f32x16*o,int vb,bf16x8 pa0,bf16x8 pa1,bf16x8 pa2,bf16x8 pa3){
  #pragma unroll
  for(int d0=0;d0<2;++d0){s16x4 lo[4],hi[4];
    #pragma unroll
    for(int ks=0;ks<4;++ks){
      asm volatile("ds_read_b64_tr_b16 %0,%1 offset:%c2":"=&v"(lo[ks]):"v"(vb),"i"(d0*4096+ks*1024):"memory");
      asm volatile("ds_read_b64_tr_b16 %0,%1 offset:%c2":"=&v"(hi[ks]):"v"(vb),"i"(d0*4096+ks*1024+512):"memory");}
    asm volatile("s_waitcnt lgkmcnt(0)":::"memory");SBAR();
    #define PK(k) (bf16x8){lo[k][0],lo[k][1],lo[k][2],lo[k][3],hi[k][0],hi[k][1],hi[k][2],hi[k][3]}
    o[d0]=__builtin_amdgcn_mfma_f32_32x32x16_bf16(pa0,PK(0),o[d0],0,0,0);
    o[d0]=__builtin_amdgcn_mfma_f32_32x32x16_bf16(pa1,PK(1),o[d0],0,0,0);
    o[d0]=__builtin_amdgcn_mfma_f32_32x32x16_bf16(pa2,PK(2),o[d0],0,0,0);
    o[d0]=__builtin_amdgcn_mfma_f32_32x32x16_bf16(pa3,PK(3),o[d0],0,0,0);
    #undef PK
  }
}

#ifndef ATTN_STORE16
#define ATTN_STORE16(p,v) (*(u32x4*)(p)=(v))
#endif
template<int THRL> __device__ __forceinline__ void attn_unit(long rowbase,int T,int h,int kvh,int qb,const bf16*__restrict__ QKV,bf16*Y,unsigned long long*ssqA,char*shm,float cref){
  int tid_=threadIdx.x; asm volatile("":"+v"(tid_)); const int tid=tid_,lane=tid&63,r32=lane&31,hi=lane>>5; const int wid=__builtin_amdgcn_readfirstlane(tid>>6);
  const int q0=qb*QB;
  const bf16*Qw=QKV+(rowbase+q0+wid*QBLK)*QP+h*D;
  const bf16*Kh=QKV+rowbase*QP+1024+kvh*D,*Vh=QKV+rowbase*QP+1536+kvh*D;
  const unsigned lds0=(unsigned)(uintptr_t)shm;
  float*wsf=(float*)(shm+LDS_WS)+wid*64;
  const bf16*ksrc=Kh+(long)lane*QP+wid*8;
  const bf16*vsrc=Vh+(long)(16*(wid&3)+(lane>>2))*QP+(wid>>2)*32+(lane&3)*8;
  const unsigned kdst=lds0+LDS_K+wid*1024, vdst=lds0+LDS_V+wid*1024;
  #define DMA_K(t,slot) glds16(ksrc+(long)(t)*KVBLK*QP,(unsigned)__builtin_amdgcn_readfirstlane(kdst+(slot)))
  #define DMA_V(t,slot) glds16(vsrc+(long)(t)*KVBLK*QP,(unsigned)__builtin_amdgcn_readfirstlane(vdst+(slot)))
  const int vb0=(int)(lds0+LDS_V)+((lane>>4)&1)*32+(lane&3)*8+(4*hi+((lane&15)>>2))*64;
  const char*Kbase=shm+LDS_K; bf16x8 kf[8];
  const lds_cptr shm3=(lds_cptr)shm; const lds_cptr kp0=shm3+LDS_K+hi*1024+r32*16; const lds_cptr vp0=shm3+LDS_V+((lane>>4)&1)*32+(lane&3)*8+(4*hi+((lane&15)>>2))*64;
  const int NT=T/KVBLK;
  DMA_K(0,0);DMA_V(0,0);DMA_K(1,SLOTB);
  bf16x8 qr[4];
  #pragma unroll
  for(int d0=0;d0<4;++d0)qr[d0]=*reinterpret_cast<const bf16x8*>(&Qw[(long)r32*QP+d0*16+hi*8]);
  float mhat=0.f,l_reg=0.f;f32x16 o[2];o[0]=f32x16{};o[1]=f32x16{};f32x16 negm;_Pragma("unroll") for(int r=0;r<16;++r)negm[r]=-cref;asm volatile("":"+v"(negm));
  const int qrel=wid*QBLK+r32;
  #define CMASK(P0,P1,t) do{}while(0)
  #define START(P0,P1) do{ _Pragma("unroll") for(int r=0;r<16;++r)P0[r]=__builtin_amdgcn_exp2f(P0[r]); }while(0)
  #define RESC() do{}while(0)
  f32x16 pA0,pA1,pB0,pB1;
  int sl_prev=0,sl_cur=0,sl_next=SLOTB;
  #define ROT() do{sl_prev=sl_cur;sl_cur=sl_next;sl_next=(sl_next==(NSLOT-1)*SLOTB)?0:sl_next+SLOTB;}while(0)
  DMA_K(2,2*SLOTB);
  WAIT_BAR(3);
  qkt(pA0,pA1,Kbase,qr,negm,r32,hi);asm volatile("s_nop 15\n\ts_nop 7":"+v"(pA0),"+v"(pA1));CMASK(pA0,pA1,0);
  START(pA0,pA1);
  _Pragma("unroll") for(int r=0;r<16;++r)pA1[r]=__builtin_amdgcn_exp2f(pA1[r]);
  WAIT_BAR(0);
  DMA_K(3,0);DMA_V(1,SLOTB);
  ROT();
  kload8(kf,kp0+sl_cur);
  WAIT_BAR(2);
  s16x4 vlo[8],vhi[8]; u32x4 pw0,pw1,pw2,pw3;
  #define PKW(P,B) cvtpk_s(P[B],P[B+1])
  #define PAF(k) __builtin_bit_cast(bf16x8,pw##k)
  #define VFR(i) (bf16x8){vlo[i][0],vlo[i][1],vlo[i][2],vlo[i][3],vhi[i][0],vhi[i][1],vhi[i][2],vhi[i][3]}
  #define PIN(x) asm volatile("":"+v"(x))
  #define MX3(a,b,c) __builtin_fmaxf(__builtin_fmaxf((a),(b)),(c))
  #define GAPA(MF,A0,A1,A2,A3,W0,W1,PW) do{ MF; sacc+=A0; sacc+=A1; sacc+=A2; sacc+=A3; PIN(sacc); W0; W1; PIN(PW); SBAR(); }while(0)
  #define EX(v) __builtin_amdgcn_exp2f(v)
  #define GAPB(MF,X,B) do{ MF; X[B]=EX(X[B]); X[B+1]=EX(X[B+1]); X[B+2]=EX(X[B+2]); X[B+3]=EX(X[B+3]); PIN(X); SBAR(); }while(0)
  #define VRD(i) do{ vlo[i]=vtr(vp_+(((i)>>2)*4096+((i)&3)*1024)); vhi[i]=vtr(vp_+(((i)>>2)*4096+((i)&3)*1024+512)); }while(0)
  #define KRD(G,j) do{ if(G){ kload2(kf,kp0+sl_next,j); SBAR(); } }while(0)
  #define STEP(C0,C1,P0,P1,t,GK,GV,GL) do{ SBAR(); \
    const lds_cptr vp_=vp0+sl_prev; \
    VRD(0); SBAR(); float sacc=(P0[0]+P0[1]); \
    GAPA(C0=__builtin_amdgcn_mfma_f32_32x32x16_bf16(kf[0],qr[0],negm,0,0,0), P0[2],P0[3],P0[4],P0[5],     pw0[0]=PKW(P0,0), pw0[1]=PKW(P0,2), pw0); \
    VRD(4); SBAR(); GAPA(C1=__builtin_amdgcn_mfma_f32_32x32x16_bf16(kf[1],qr[0],negm,0,0,0), P0[6],P0[7],P0[8],P0[9],     pw0[2]=PKW(P0,4), pw0[3]=PKW(P0,6), pw0); \
    VRD(1); SBAR(); GAPA(C0=__builtin_amdgcn_mfma_f32_32x32x16_bf16(kf[2],qr[1],C0,0,0,0),   P0[10],P0[11],P0[12],P0[13], pw1[0]=PKW(P0,8), pw1[1]=PKW(P0,10), pw1); \
    VRD(5); SBAR(); GAPA(C1=__builtin_amdgcn_mfma_f32_32x32x16_bf16(kf[3],qr[1],C1,0,0,0),   P0[14],P0[15],P1[0],P1[1],   pw1[2]=PKW(P0,12),pw1[3]=PKW(P0,14), pw1); \
    VRD(2); SBAR(); GAPA(C0=__builtin_amdgcn_mfma_f32_32x32x16_bf16(kf[4],qr[2],C0,0,0,0),   P1[2],P1[3],P1[4],P1[5],     pw2[0]=PKW(P1,0), pw2[1]=PKW(P1,2), pw2); \
    VRD(6); SBAR(); GAPA(C1=__builtin_amdgcn_mfma_f32_32x32x16_bf16(kf[5],qr[2],C1,0,0,0),   P1[6],P1[7],P1[8],P1[9],     pw2[2]=PKW(P1,4), pw2[3]=PKW(P1,6), pw2); \
    VRD(3); SBAR(); GAPA(C0=__builtin_amdgcn_mfma_f32_32x32x16_bf16(kf[6],qr[3],C0,0,0,0),   P1[10],P1[11],P1[12],P1[13], pw3[0]=PKW(P1,8), pw3[1]=PKW(P1,10), pw3); \
    VRD(7); SBAR(); GAPA(C1=__builtin_amdgcn_mfma_f32_32x32x16_bf16(kf[7],qr[3],C1,0,0,0),   P1[14],P1[15],0.f,0.f,       pw3[2]=PKW(P1,12),pw3[3]=PKW(P1,14), pw3); \
    l_reg+=sacc; \
    if(GK){DMA_K((t)+3,sl_cur);} if(GV){DMA_V((t)+1,sl_next);} \
    CMASK(C0,C1,t); \
    SBAR(); \
    GAPB(o[0]=__builtin_amdgcn_mfma_f32_32x32x16_bf16(PAF(0),VFR(0),o[0],0,0,0), C0,0); \
    GAPB(o[1]=__builtin_amdgcn_mfma_f32_32x32x16_bf16(PAF(0),VFR(4),o[1],0,0,0), C0,4); \
    KRD(GL,0); GAPB(o[0]=__builtin_amdgcn_mfma_f32_32x32x16_bf16(PAF(1),VFR(1),o[0],0,0,0), C0,8); \
    KRD(GL,1); GAPB(o[1]=__builtin_amdgcn_mfma_f32_32x32x16_bf16(PAF(1),VFR(5),o[1],0,0,0), C0,12); \
    KRD(GL,2); GAPB(o[0]=__builtin_amdgcn_mfma_f32_32x32x16_bf16(PAF(2),VFR(2),o[0],0,0,0), C1,0); \
    KRD(GL,3); GAPB(o[1]=__builtin_amdgcn_mfma_f32_32x32x16_bf16(PAF(2),VFR(6),o[1],0,0,0), C1,4); \
    GAPB(o[0]=__builtin_amdgcn_mfma_f32_32x32x16_bf16(PAF(3),VFR(3),o[0],0,0,0), C1,8); \
    GAPB(o[1]=__builtin_amdgcn_mfma_f32_32x32x16_bf16(PAF(3),VFR(7),o[1],0,0,0), C1,12); \
    }while(0)
  int t=1;
  #undef CMASK
  #define CMASK(P0,P1,t) do{}while(0)
  for(;t+5<NT;t+=2){
    STEP(pB0,pB1,pA0,pA1,t,true,true,true);     WAIT_BAR(2); RESC(); ROT();
    STEP(pA0,pA1,pB0,pB1,t+1,true,true,true);   WAIT_BAR(2); RESC(); ROT();
  }
  #undef CMASK
  #define CMASK(P0,P1,t) do{}while(0)
  #define ENDW(tt) do{ if((tt)+3<NT){WAIT_BAR(2);} else if((tt)+2<NT){WAIT_BAR(1);} else {WAIT_BAR(0);} }while(0)
  for(;t+1<NT;t+=2){
    STEP(pB0,pB1,pA0,pA1,t,(t+3<NT),(t+1<NT),(t+1<NT));       ENDW(t);   RESC(); ROT();
    STEP(pA0,pA1,pB0,pB1,t+1,(t+4<NT),(t+2<NT),(t+2<NT));     ENDW(t+1); RESC(); ROT();
  }
  STEP(pB0,pB1,pA0,pA1,NT-1,false,false,false); RESC();
  { float sacc=pB0[0]+pB0[1]; _Pragma("unroll") for(int r=2;r<16;++r)sacc+=pB0[r]; _Pragma("unroll") for(int r=0;r<16;++r)sacc+=pB1[r]; l_reg+=sacc;
    pw0=(u32x4){PKW(pB0,0),PKW(pB0,2),PKW(pB0,4),PKW(pB0,6)};pw1=(u32x4){PKW(pB0,8),PKW(pB0,10),PKW(pB0,12),PKW(pB0,14)};pw2=(u32x4){PKW(pB1,0),PKW(pB1,2),PKW(pB1,4),PKW(pB1,6)};pw3=(u32x4){PKW(pB1,8),PKW(pB1,10),PKW(pB1,12),PKW(pB1,14)};
    SBAR(); pv(o,vb0+sl_cur,PAF(0),PAF(1),PAF(2),PAF(3)); }
  #undef PKW
  #undef PAF
  #undef VFR
  #undef PIN
  #undef MX3
  #undef GAPA
  #undef GAPB
  #undef EX
  #undef VRD
  #undef KRD
  #undef STEP
  #undef ENDW
  {auto rr=__builtin_amdgcn_permlane32_swap(__float_as_uint(l_reg),__float_as_uint(l_reg),false,false);l_reg=__uint_as_float(rr[0])+__uint_as_float(rr[1]);}
  if(hi==0)wsf[32+r32]=l_reg;asm volatile("s_waitcnt lgkmcnt(0)":::"memory");
  float rli[16];
  #pragma unroll
  for(int r=0;r<16;++r)rli[r]=__builtin_amdgcn_rcpf(wsf[32+crow(r,hi)]);
  bf16*Ow=Y+(rowbase+q0+wid*QBLK)*OP+h*D; unsigned long long*sqw=ssqA+rowbase+q0+wid*QBLK;
  { bf16*stg=(bf16*)(shm+LDS_OST)+wid*2048;
    #pragma unroll
    for(int r=0;r<16;++r){const int orow=crow(r,hi);
      #pragma unroll
      for(int d0=0;d0<2;++d0)stg[orow*64+d0*32+r32]=__float2bfloat16(o[d0][r]*rli[r]);}
    asm volatile("s_waitcnt lgkmcnt(0)":::"memory");
    #pragma unroll
    for(int i=0;i<4;++i){const int row=i*8+(lane>>3),ch=lane&7; const u32x4 v=*(const u32x4*)(stg+row*64+ch*8); ATTN_STORE16(Ow+(long)row*OP+ch*8,v);
      float ss=0.f;
      #pragma unroll
      for(int w_=0;w_<4;++w_){const float a_=__uint_as_float(v[w_]<<16),b_=__uint_as_float(v[w_]&0xffff0000u);ss+=a_*a_+b_*b_;}
      ss+=__shfl_xor(ss,1);ss+=__shfl_xor(ss,2);ss+=__shfl_xor(ss,4); if(ch==0)atomicAdd(sqw+row,(unsigned long long)(ss*1073741824.0f));} }
  asm volatile("s_waitcnt lgkmcnt(0)\n\ts_barrier":::"memory");
  #undef DMA_K
  #undef DMA_V
  #undef CMASK
  #undef START
  #undef RESC
  #undef ROT
}
constexpr int ATTN_LDS_BYTES=LDS_BYTES;
#undef SBAR
#undef WAIT_BAR
}
namespace loc {
typedef unsigned short bf16_t;
typedef short bf16x8 __attribute__((ext_vector_type(8)));
typedef short s16x4 __attribute__((ext_vector_type(4)));
typedef float f32x4 __attribute__((ext_vector_type(4)));
typedef unsigned u32x4 __attribute__((ext_vector_type(4)));
typedef unsigned u32x2 __attribute__((ext_vector_type(2)));
#define LOC_LAS __attribute__((address_space(3)))
constexpr int VPITCH = 144;
constexpr int VBUF_BYTES = 32 * VPITCH;
__device__ __forceinline__ s16x4 trd(LOC_LAS char* p) { return __builtin_bit_cast(s16x4, __builtin_amdgcn_ds_read_tr16_b64_v4i16((LOC_LAS s16x4*)p)); }
typedef float f32x2_t __attribute__((ext_vector_type(2))); typedef __bf16 bf16x2_t __attribute__((ext_vector_type(2)));
__device__ __forceinline__ unsigned pk2(float lo, float hi) { f32x2_t v = {lo, hi}; bf16x2_t b = __builtin_convertvector(v, bf16x2_t); return __builtin_bit_cast(unsigned, b); }
__device__ __forceinline__ int clampi(int v, int lo, int hi) { return v < lo ? lo : (v > hi ? hi : v); }

template <int MIX>
__device__ __forceinline__ void local_unit(const bf16_t* __restrict__ QKV, const bf16_t* __restrict__ KVC, bf16_t* Y, const LOC_LAS float* rpbL, LOC_LAS char* vbuf,
                                           long seqrow, int T, int q0, int lane, float negC, LOC_LAS char* img, int rho_l, int imgpos0) {
    const int fr = lane & 15, g = lane >> 4;
    constexpr int QS = (MIX == 1) ? 1 : 16;
    const int qpos = q0 + QS * fr;
    float ss = 0.f;
#pragma unroll 1
    for (int pair = 0; pair < 3; ++pair) {
    const int qh0 = (MIX == 1 ? 4 : 10) + 2 * pair, kvh = (MIX == 1 ? 2 : 5) + pair;
    const bf16_t* qrow = QKV + (size_t)(seqrow + qpos) * 2048 + qh0 * 64 + 8 * g;
    bf16x8 qf[2][2];
#pragma unroll
    for (int h = 0; h < 2; ++h)
#pragma unroll
        for (int ks = 0; ks < 2; ++ks) qf[h][ks] = *(const bf16x8*)(qrow + h * 64 + 32 * ks);
    f32x4 o[2][4];
#pragma unroll
    for (int h = 0; h < 2; ++h)
#pragma unroll
        for (int c = 0; c < 4; ++c) o[h][c] = (f32x4){0.f, 0.f, 0.f, 0.f};
    float ls[2] = {0.f, 0.f};
    const int kvl = (MIX == 1 ? 0 : 3) + pair;
    const bf16_t* Kb = KVC + ((size_t)kvl * 49152 + seqrow) * 128 + 8 * g;
    const bf16_t* Vb = KVC + ((size_t)kvl * 49152 + seqrow) * 128 + 64 + (lane & 7) * 8;
    constexpr int NTILES = (MIX == 1) ? 8 : 23;
    constexpr int NG = (MIX == 1) ? 8 : 11;
    if (MIX == 2) {
        __syncthreads();
        const int t512 = rho_l * 64 + lane;
        const bf16_t* src = KVC + ((size_t)kvl * 49152 + seqrow) * 128;
        u32x4 w[12];
#pragma unroll
        for (int j = 0; j < 12; ++j) { const int cch = t512 + 512 * j, key = cch >> 4, part = cch & 15; const int kp = clampi(imgpos0 + key, 0, T - 1); w[j] = *(const u32x4*)(src + (size_t)kp * 128 + part * 8); }
#pragma unroll
        for (int j = 0; j < 12; ++j) { const int cch = t512 + 512 * j, key = cch >> 4, part = cch & 15;
            LOC_LAS char* d = (part < 8) ? img + key * 128 + ((part ^ (key & 7)) * 16) : img + 49152 + key * 128 + (((((part - 8) >> 1) ^ ((key >> 1) & 3)) * 2 + (part & 1)) * 16);
            *(LOC_LAS u32x4*)d = w[j]; }
        __syncthreads();
    }
    const int r = q0 >> 6, c = (q0 & 63) + fr, c0 = clampi(c - 8, 0, 48), r0 = clampi(r - 4, 0, (T >> 6) - 8), jq = (q0 & 63) >> 4;
    const int cb = jq == 0 ? 0 : (jq == 1 ? 8 : (jq == 2 ? 24 : 32));
    LOC_LAS char* vwr = vbuf + (lane >> 3) * VPITCH + (lane & 7) * 16;
    LOC_LAS char* vrd = vbuf + (4 * g + ((lane & 15) >> 2)) * VPITCH + (lane & 3) * 8;
    bf16x8 kn[2][2]; u32x4 vn[4];
#define LOC_TILE(it_, base_, s_) do { if (MIX == 1) { base_ = (r0 + (it_)) * 64 + cb; s_ = 1; } \
        else { if ((it_) < 5) { s_ = 16; base_ = q0 - 1024 + 512 * (it_); } else if ((it_) < 11) { s_ = 4; base_ = q0 - 256 + 128 * ((it_) - 5); } else { s_ = 1; base_ = q0 - 64 + 32 * ((it_) - 11); } } } while (0)
#define LOC_ISSUE(it_) do { int b_, s_; LOC_TILE(it_, b_, s_); \
        _Pragma("unroll") for (int ab = 0; ab < 2; ++ab) { const int kp = clampi(b_ + s_ * (16 * ab + fr), 0, T - 1); const bf16_t* p = Kb + (size_t)kp * 128; kn[ab][0] = *(const bf16x8*)p; kn[ab][1] = *(const bf16x8*)(p + 32); } \
        _Pragma("unroll") for (int i_ = 0; i_ < 4; ++i_) { const int kp = clampi(b_ + s_ * (8 * i_ + (lane >> 3)), 0, T - 1); vn[i_] = *(const u32x4*)(Vb + (size_t)kp * 128); } } while (0)
    LOC_ISSUE(0);
    for (int it = 0; it < NG; ++it) {
        int base, s; LOC_TILE(it, base, s);
        bf16x8 kf[2][2];
        constexpr bool fromimg = false;
        const int kbase = rho_l + 32 * (it - NG);
        if (!fromimg) {
#pragma unroll
            for (int ab = 0; ab < 2; ++ab) { kf[ab][0] = kn[ab][0]; kf[ab][1] = kn[ab][1]; }
            const u32x4 v0 = vn[0], v1 = vn[1], v2 = vn[2], v3 = vn[3];
            asm volatile("" : : "v"(kf[0][0]), "v"(kf[0][1]), "v"(kf[1][0]), "v"(kf[1][1]), "v"(v0), "v"(v1), "v"(v2), "v"(v3) : "memory");
            *(LOC_LAS u32x4*)(vwr) = v0; *(LOC_LAS u32x4*)(vwr + 8 * VPITCH) = v1; *(LOC_LAS u32x4*)(vwr + 16 * VPITCH) = v2; *(LOC_LAS u32x4*)(vwr + 24 * VPITCH) = v3;
            if (it + 1 < NG) LOC_ISSUE(it + 1);
        } else {
#pragma unroll
            for (int ab = 0; ab < 2; ++ab) { const int k = clampi(kbase + 16 * ab + fr, 0, 383); const LOC_LAS char* p = img + k * 128;
                kf[ab][0] = *(const LOC_LAS bf16x8*)(p + (((0 + g) ^ (k & 7)) * 16)); kf[ab][1] = *(const LOC_LAS bf16x8*)(p + (((4 + g) ^ (k & 7)) * 16)); }
        }
        asm volatile("" ::: "memory");
        f32x4 ini[2][2];
#pragma unroll
        for (int ab = 0; ab < 2; ++ab)
#pragma unroll
            for (int e = 0; e < 4; ++e) { const int j = 16 * ab + 4 * g + e;
                if (MIX == 1) { const int kc = cb + j; const bool valid = (unsigned)(kc - c0) < 16u; const int bidx = valid ? ((r0 + it - r + 7) * 31 + (kc - c + 15)) : 0;
                    float b0 = rpbL[(2 * pair) * 465 + bidx], b1 = rpbL[(2 * pair + 1) * 465 + bidx]; asm volatile("" : "+v"(b0), "+v"(b1));
                    ini[0][ab][e] = valid ? b0 : -1e30f; ini[1][ab][e] = valid ? b1 : -1e30f; }
                else { const int kp = base + s * j; const int dd = kp - qpos; const bool valid = ((unsigned)kp < (unsigned)T) & ((unsigned)(dd + 64 * s) <= (unsigned)(128 * s));
                    ini[0][ab][e] = valid ? negC : -1e30f; ini[1][ab][e] = ini[0][ab][e]; } }
        f32x4 sc[2][2];
#pragma unroll
        for (int h = 0; h < 2; ++h)
#pragma unroll
            for (int ab = 0; ab < 2; ++ab) { sc[h][ab] = __builtin_amdgcn_mfma_f32_16x16x32_bf16(kf[ab][0], qf[h][0], ini[h][ab], 0, 0, 0);
                sc[h][ab] = __builtin_amdgcn_mfma_f32_16x16x32_bf16(kf[ab][1], qf[h][1], sc[h][ab], 0, 0, 0); }
        bf16x8 vf[4];
#pragma unroll
        for (int cc = 0; cc < 4; ++cc) { LOC_LAS char* plo = vrd + cc * 32; LOC_LAS char* phi = vrd + 16 * VPITCH + cc * 32;
            if (fromimg) { const int qq = (lane & 15) >> 2, rlo = clampi(kbase + 4 * g + qq, 0, 383), rhi = clampi(kbase + 16 + 4 * g + qq, 0, 383);
                plo = img + 49152 + rlo * 128 + ((cc ^ ((rlo >> 1) & 3)) * 32) + (lane & 3) * 8; phi = img + 49152 + rhi * 128 + ((cc ^ ((rhi >> 1) & 3)) * 32) + (lane & 3) * 8; }
            const s16x4 lo = trd(plo), hi = trd(phi); vf[cc] = (bf16x8){lo[0], lo[1], lo[2], lo[3], hi[0], hi[1], hi[2], hi[3]}; }
        bf16x8 pf[2];
#pragma unroll
        for (int h = 0; h < 2; ++h) {
            float p[2][4]; float psum = 0.f;
#pragma unroll
            for (int ab = 0; ab < 2; ++ab)
#pragma unroll
                for (int e = 0; e < 4; ++e) { p[ab][e] = __builtin_amdgcn_exp2f(sc[h][ab][e]); psum += p[ab][e]; }
            ls[h] += psum;
            u32x4 w; w.x = pk2(p[0][0], p[0][1]); w.y = pk2(p[0][2], p[0][3]); w.z = pk2(p[1][0], p[1][1]); w.w = pk2(p[1][2], p[1][3]);
            pf[h] = __builtin_bit_cast(bf16x8, w);
        }
#pragma unroll
        for (int cc = 0; cc < 4; ++cc) {
            o[0][cc] = __builtin_amdgcn_mfma_f32_16x16x32_bf16(vf[cc], pf[0], o[0][cc], 0, 0, 0);
            o[1][cc] = __builtin_amdgcn_mfma_f32_16x16x32_bf16(vf[cc], pf[1], o[1][cc], 0, 0, 0);
        }
        asm volatile("" ::: "memory");
    }
    if (MIX == 2) {
#pragma unroll 4
    for (int it = NG; it < NTILES; ++it) {
        int base, s; LOC_TILE(it, base, s);
        bf16x8 kf[2][2];
        constexpr bool fromimg = true;
        const int kbase = rho_l + 32 * (it - NG);
        if (!fromimg) {
#pragma unroll
            for (int ab = 0; ab < 2; ++ab) { kf[ab][0] = kn[ab][0]; kf[ab][1] = kn[ab][1]; }
            const u32x4 v0 = vn[0], v1 = vn[1], v2 = vn[2], v3 = vn[3];
            asm volatile("" : : "v"(kf[0][0]), "v"(kf[0][1]), "v"(kf[1][0]), "v"(kf[1][1]), "v"(v0), "v"(v1), "v"(v2), "v"(v3) : "memory");
            *(LOC_LAS u32x4*)(vwr) = v0; *(LOC_LAS u32x4*)(vwr + 8 * VPITCH) = v1; *(LOC_LAS u32x4*)(vwr + 16 * VPITCH) = v2; *(LOC_LAS u32x4*)(vwr + 24 * VPITCH) = v3;
            if (it + 1 < NG) LOC_ISSUE(it + 1);
        } else {
#pragma unroll
            for (int ab = 0; ab < 2; ++ab) { const int k = clampi(kbase + 16 * ab + fr, 0, 383); const LOC_LAS char* p = img + k * 128;
                kf[ab][0] = *(const LOC_LAS bf16x8*)(p + (((0 + g) ^ (k & 7)) * 16)); kf[ab][1] = *(const LOC_LAS bf16x8*)(p + (((4 + g) ^ (k & 7)) * 16)); }
        }
        f32x4 ini[2][2];
#pragma unroll
        for (int ab = 0; ab < 2; ++ab)
#pragma unroll
            for (int e = 0; e < 4; ++e) { const int j = 16 * ab + 4 * g + e;
                if (MIX == 1) { const int kc = cb + j; const bool valid = (unsigned)(kc - c0) < 16u; const int bidx = valid ? ((r0 + it - r + 7) * 31 + (kc - c + 15)) : 0;
                    float b0 = rpbL[(2 * pair) * 465 + bidx], b1 = rpbL[(2 * pair + 1) * 465 + bidx]; asm volatile("" : "+v"(b0), "+v"(b1));
                    ini[0][ab][e] = valid ? b0 : -1e30f; ini[1][ab][e] = valid ? b1 : -1e30f; }
                else { const int kp = base + s * j; const int dd = kp - qpos; const bool valid = ((unsigned)kp < (unsigned)T) & ((unsigned)(dd + 64 * s) <= (unsigned)(128 * s));
                    ini[0][ab][e] = valid ? negC : -1e30f; ini[1][ab][e] = ini[0][ab][e]; } }
        f32x4 sc[2][2];
#pragma unroll
        for (int h = 0; h < 2; ++h)
#pragma unroll
            for (int ab = 0; ab < 2; ++ab) { sc[h][ab] = __builtin_amdgcn_mfma_f32_16x16x32_bf16(kf[ab][0], qf[h][0], ini[h][ab], 0, 0, 0);
                sc[h][ab] = __builtin_amdgcn_mfma_f32_16x16x32_bf16(kf[ab][1], qf[h][1], sc[h][ab], 0, 0, 0); }
        bf16x8 vf[4];
#pragma unroll
        for (int cc = 0; cc < 4; ++cc) { LOC_LAS char* plo = vrd + cc * 32; LOC_LAS char* phi = vrd + 16 * VPITCH + cc * 32;
            if (fromimg) { const int qq = (lane & 15) >> 2, rlo = clampi(kbase + 4 * g + qq, 0, 383), rhi = clampi(kbase + 16 + 4 * g + qq, 0, 383);
                plo = img + 49152 + rlo * 128 + ((cc ^ ((rlo >> 1) & 3)) * 32) + (lane & 3) * 8; phi = img + 49152 + rhi * 128 + ((cc ^ ((rhi >> 1) & 3)) * 32) + (lane & 3) * 8; }
            const s16x4 lo = trd(plo), hi = trd(phi); vf[cc] = (bf16x8){lo[0], lo[1], lo[2], lo[3], hi[0], hi[1], hi[2], hi[3]}; }
        bf16x8 pf[2];
#pragma unroll
        for (int h = 0; h < 2; ++h) {
            float p[2][4]; float psum = 0.f;
#pragma unroll
            for (int ab = 0; ab < 2; ++ab)
#pragma unroll
                for (int e = 0; e < 4; ++e) { p[ab][e] = __builtin_amdgcn_exp2f(sc[h][ab][e]); psum += p[ab][e]; }
            ls[h] += psum;
            u32x4 w; w.x = pk2(p[0][0], p[0][1]); w.y = pk2(p[0][2], p[0][3]); w.z = pk2(p[1][0], p[1][1]); w.w = pk2(p[1][2], p[1][3]);
            pf[h] = __builtin_bit_cast(bf16x8, w);
        }
#pragma unroll
        for (int cc = 0; cc < 4; ++cc) {
            o[0][cc] = __builtin_amdgcn_mfma_f32_16x16x32_bf16(vf[cc], pf[0], o[0][cc], 0, 0, 0);
            o[1][cc] = __builtin_amdgcn_mfma_f32_16x16x32_bf16(vf[cc], pf[1], o[1][cc], 0, 0, 0);
        }
    }
    }
    bf16_t* yrow = Y + (size_t)(seqrow + qpos) * 1024 + qh0 * 64 + 4 * g;
#pragma unroll
    for (int h = 0; h < 2; ++h) {
        float l = ls[h]; l += __shfl_xor(l, 16); l += __shfl_xor(l, 32);
        const float inv = 1.0f / l;
#pragma unroll
        for (int cc = 0; cc < 4; ++cc) { const f32x4 v = o[h][cc] * inv; u32x2 w; w.x = pk2(v[0], v[1]); w.y = pk2(v[2], v[3]);
            *(u32x2*)(yrow + h * 64 + 16 * cc) = w;
            const float a0 = __uint_as_float(w.x << 16), a1 = __uint_as_float(w.x & 0xffff0000u), a2 = __uint_as_float(w.y << 16), a3 = __uint_as_float(w.y & 0xffff0000u);
            ss += (a0 * a0 + a1 * a1) + (a2 * a2 + a3 * a3); }
    }
    }
    ss += __shfl_xor(ss, 16); ss += __shfl_xor(ss, 32);
    const float f = rsqrtf(ss * (1.0f / 384.0f) + 1e-6f);
    asm volatile("s_waitcnt vmcnt(0)" ::: "memory");
    { bf16_t* yb = Y + (size_t)(seqrow + qpos) * 1024 + (MIX == 1 ? 4 : 10) * 64 + 4 * g;
      u32x2 w[24];
#pragma unroll
      for (int i = 0; i < 24; ++i) w[i] = *(const u32x2*)(yb + 16 * i);
#pragma unroll
      for (int i = 0; i < 24; ++i) { u32x2 v = w[i]; v.x = pk2(__uint_as_float(v.x << 16) * f, __uint_as_float(v.x & 0xffff0000u) * f); v.y = pk2(__uint_as_float(v.y << 16) * f, __uint_as_float(v.y & 0xffff0000u) * f);
          *(u32x2*)(yb + 16 * i) = v; } }
}
#undef LOC_TILE
#undef LOC_ISSUE

__device__ __forceinline__ void local_unit_nb(const bf16_t* __restrict__ QKV, const bf16_t* __restrict__ KVC, bf16_t* Y, const LOC_LAS float* rpbL, LOC_LAS char* img,
                                              long seqrow, int T, int gr0, int wave, int lane) {
    const int fr = lane & 15, g = lane >> 4;
    const int rows = T >> 6;
    const int r = gr0 + (wave >> 2), jq = wave & 3;
    const int q0 = r * 64 + 16 * jq, qpos = q0 + fr;
    const int c = 16 * jq + fr, c0 = clampi(c - 8, 0, 48), r0 = clampi(r - 4, 0, rows - 8);
    const int cb = jq == 0 ? 0 : (jq == 1 ? 8 : (jq == 2 ? 24 : 32));
    const int R0 = clampi(gr0 - 4, 0, rows - 8);
    const int t512 = wave * 64 + lane;
    const bf16_t* src0 = KVC + (size_t)seqrow * 128;
    float ss = 0.f;
    u32x4 w[6];
#define NB_LOAD(q_) do { const bf16_t* s_ = src0 + (size_t)((q_) / 3) * 49152 * 128; const int p0_ = (R0 + 3 * ((q_) % 3)) * 64; \
        _Pragma("unroll") for (int j = 0; j < 6; ++j) { const int cch = t512 + 512 * j, key = cch >> 4, part = cch & 15; const int kp = clampi(p0_ + key, 0, T - 1); w[j] = *(const u32x4*)(s_ + (size_t)kp * 128 + part * 8); } } while (0)
#define NB_STORE(q_) do { LOC_LAS char* b_ = img + ((q_) & 1) * 49152; \
        _Pragma("unroll") for (int j = 0; j < 6; ++j) { const int cch = t512 + 512 * j, key = cch >> 4, part = cch & 15; \
            LOC_LAS char* d = (part < 8) ? b_ + key * 128 + ((part ^ (key & 7)) * 16) : b_ + 24576 + key * 128 + (((((part - 8) >> 1) ^ ((key >> 1) & 3)) * 2 + (part & 1)) * 16); \
            *(LOC_LAS u32x4*)d = w[j]; } } while (0)
    __syncthreads();
    NB_LOAD(0); NB_STORE(0);
    __syncthreads();
    bf16x8 qf[2][2]; f32x4 o[2][4]; float ls[2];
#pragma unroll 1
    for (int q = 0; q < 9; ++q) {
        const int pair = q / 3, pass = q - 3 * pair;
        if (q + 1 < 9) NB_LOAD(q + 1);
        if (pass == 0) {
            const bf16_t* qrow = QKV + (size_t)(seqrow + qpos) * 2048 + (4 + 2 * pair) * 64 + 8 * g;
#pragma unroll
            for (int h = 0; h < 2; ++h)
#pragma unroll
                for (int ks = 0; ks < 2; ++ks) qf[h][ks] = *(const bf16x8*)(qrow + h * 64 + 32 * ks);
#pragma unroll
            for (int h = 0; h < 2; ++h)
#pragma unroll
                for (int cc = 0; cc < 4; ++cc) o[h][cc] = (f32x4){0.f, 0.f, 0.f, 0.f};
            ls[0] = 0.f; ls[1] = 0.f;
        }
        LOC_LAS char* ib = img + (q & 1) * 49152;
        const int Rp = R0 + 3 * pass;
        const int klo = r0 > Rp ? r0 : Rp, khi = (r0 + 8 < Rp + 3) ? r0 + 8 : Rp + 3;
#pragma unroll 3
        for (int kr = klo; kr < khi; ++kr) {
            const int kbase = (kr - Rp) * 64 + cb;
            bf16x8 kf[2][2];
#pragma unroll
            for (int ab = 0; ab < 2; ++ab) { const int k = kbase + 16 * ab + fr; const LOC_LAS char* p = ib + k * 128;
                kf[ab][0] = *(const LOC_LAS bf16x8*)(p + (((0 + g) ^ (k & 7)) * 16)); kf[ab][1] = *(const LOC_LAS bf16x8*)(p + (((4 + g) ^ (k & 7)) * 16)); }
            f32x4 ini[2][2];
#pragma unroll
            for (int ab = 0; ab < 2; ++ab)
#pragma unroll
                for (int e = 0; e < 4; ++e) { const int kc = cb + 16 * ab + 4 * g + e; const bool valid = (unsigned)(kc - c0) < 16u; const int bidx = valid ? ((kr - r + 7) * 31 + (kc - c + 15)) : 0;
                    ini[0][ab][e] = rpbL[(2 * pair) * 465 + bidx]; ini[1][ab][e] = rpbL[(2 * pair + 1) * 465 + bidx]; }
            asm volatile("" : "+v"(ini[0][0]), "+v"(ini[0][1]), "+v"(ini[1][0]), "+v"(ini[1][1]));
#pragma unroll
            for (int ab = 0; ab < 2; ++ab)
#pragma unroll
                for (int e = 0; e < 4; ++e) { const int kc = cb + 16 * ab + 4 * g + e; const bool valid = (unsigned)(kc - c0) < 16u;
                    ini[0][ab][e] = valid ? ini[0][ab][e] : -1e30f; ini[1][ab][e] = valid ? ini[1][ab][e] : -1e30f; }
            f32x4 sc[2][2];
#pragma unroll
            for (int h = 0; h < 2; ++h)
#pragma unroll
                for (int ab = 0; ab < 2; ++ab) { sc[h][ab] = __builtin_amdgcn_mfma_f32_16x16x32_bf16(kf[ab][0], qf[h][0], ini[h][ab], 0, 0, 0);
                    sc[h][ab] = __builtin_amdgcn_mfma_f32_16x16x32_bf16(kf[ab][1], qf[h][1], sc[h][ab], 0, 0, 0); }
            bf16x8 vf[4];
#pragma unroll
            for (int cc = 0; cc < 4; ++cc) { const int qq = (lane & 15) >> 2; const int rlo = kbase + 4 * g + qq, rhi = rlo + 16;
                LOC_LAS char* plo = ib + 24576 + rlo * 128 + ((cc ^ ((rlo >> 1) & 3)) * 32) + (lane & 3) * 8; LOC_LAS char* phi = ib + 24576 + rhi * 128 + ((cc ^ ((rhi >> 1) & 3)) * 32) + (lane & 3) * 8;
                const s16x4 lo = trd(plo), hi = trd(phi); vf[cc] = (bf16x8){lo[0], lo[1], lo[2], lo[3], hi[0], hi[1], hi[2], hi[3]}; }
            bf16x8 pf[2];
#pragma unroll
            for (int h = 0; h < 2; ++h) {
                float p[2][4]; float psum = 0.f;
#pragma unroll
                for (int ab = 0; ab < 2; ++ab)
#pragma unroll
                    for (int e = 0; e < 4; ++e) { p[ab][e] = __builtin_amdgcn_exp2f(sc[h][ab][e]); psum += p[ab][e]; }
                ls[h] += psum;
                u32x4 w_; w_.x = pk2(p[0][0], p[0][1]); w_.y = pk2(p[0][2], p[0][3]); w_.z = pk2(p[1][0], p[1][1]); w_.w = pk2(p[1][2], p[1][3]);
                pf[h] = __builtin_bit_cast(bf16x8, w_);
            }
#pragma unroll
            for (int cc = 0; cc < 4; ++cc) {
                o[0][cc] = __builtin_amdgcn_mfma_f32_16x16x32_bf16(vf[cc], pf[0], o[0][cc], 0, 0, 0);
                o[1][cc] = __builtin_amdgcn_mfma_f32_16x16x32_bf16(vf[cc], pf[1], o[1][cc], 0, 0, 0);
            }
        }
        if (pass == 2) {
            bf16_t* yrow = Y + (size_t)(seqrow + qpos) * 1024 + (4 + 2 * pair) * 64 + 4 * g;
#pragma unroll
            for (int h = 0; h < 2; ++h) {
                float l_ = ls[h]; l_ += __shfl_xor(l_, 16); l_ += __shfl_xor(l_, 32);
                const float inv = 1.0f / l_;
#pragma unroll
                for (int cc = 0; cc < 4; ++cc) { const f32x4 v = o[h][cc] * inv; u32x2 w2; w2.x = pk2(v[0], v[1]); w2.y = pk2(v[2], v[3]);
                    *(u32x2*)(yrow + h * 64 + 16 * cc) = w2;
                    const float a0 = __uint_as_float(w2.x << 16), a1 = __uint_as_float(w2.x & 0xffff0000u), a2 = __uint_as_float(w2.y << 16), a3 = __uint_as_float(w2.y & 0xffff0000u);
                    ss += (a0 * a0 + a1 * a1) + (a2 * a2 + a3 * a3); }
            }
        }
        if (q + 1 < 9) NB_STORE(q + 1);
        __syncthreads();
    }
#undef NB_LOAD
#undef NB_STORE
    ss += __shfl_xor(ss, 16); ss += __shfl_xor(ss, 32);
    const float f = rsqrtf(ss * (1.0f / 384.0f) + 1e-6f);
    asm volatile("s_waitcnt vmcnt(0)" ::: "memory");
    { bf16_t* yb = Y + (size_t)(seqrow + qpos) * 1024 + 4 * 64 + 4 * g;
      u32x2 w3[24];
#pragma unroll
      for (int i = 0; i < 24; ++i) w3[i] = *(const u32x2*)(yb + 16 * i);
#pragma unroll
      for (int i = 0; i < 24; ++i) { u32x2 v = w3[i]; v.x = pk2(__uint_as_float(v.x << 16) * f, __uint_as_float(v.x & 0xffff0000u) * f); v.y = pk2(__uint_as_float(v.y << 16) * f, __uint_as_float(v.y & 0xffff0000u) * f);
          *(u32x2*)(yb + 16 * i) = v; } }
}
}
#include <hip/hip_cooperative_groups.h>
namespace cg = cooperative_groups;
#define LAS __attribute__((address_space(3)))
typedef unsigned short bf16;
typedef unsigned v4u __attribute__((ext_vector_type(4)));
typedef float f32x4 __attribute__((ext_vector_type(4)));

constexpr int DM = 1024, DEPTH = 4, QKVW = 2048, FF = 2816, M_TOK = 49152, M_PROMPT = 16384;
constexpr size_t MiB = 1u << 20;
constexpr size_t WS_CTL = 0;
constexpr size_t WS_TAB = 1 * MiB;
constexpr size_t WS_SSQ = 482 * MiB;
constexpr size_t WS_W = 8 * MiB;
constexpr size_t WS_XB = 98 * MiB;
constexpr size_t WS_QKV = 194 * MiB;
constexpr size_t WS_Y = 386 * MiB;
constexpr size_t WS_H = 194 * MiB;
constexpr size_t WS_END = 490 * MiB;
constexpr size_t W_IN = 0, W_OUT = 2097152, W_GU = 3145728, W_DOWN = 8912896, W_LAYER = 11796480;
#ifndef PG_ALIGN
#define PG_ALIGN true
#endif
#ifndef PG_SP2
#define PG_SP2 true
#endif
constexpr int LDS_BYTES = 147456;
constexpr int MISC_OFF = 147392;
constexpr int BND_OFF = 264192 + 4 * 384;
constexpr int RPB_OFF = 135168;
constexpr int N_LOCAL_ITEMS = 18432;

struct Args { const float* in[12]; float* out; unsigned char* ws; };

__device__ __forceinline__ unsigned f2bf(float f) { unsigned u = __builtin_bit_cast(unsigned, f); return (u + 0x7fffu + ((u >> 16) & 1u)) >> 16; }
__device__ __forceinline__ unsigned pk2h(float lo, float hi) { return f2bf(lo) | (f2bf(hi) << 16); }
__device__ __forceinline__ float wave_sum(float v) {
#pragma unroll
    for (int o = 1; o < 64; o <<= 1) v += __shfl_xor(v, o);
    return v;
}
__device__ __forceinline__ int jrow(int kind, int n) {
    if (kind == 0) {
        const int hd = n >> 6, d = n & 63, pn = hd >> 2, wc = hd & 3;
        const bool typeA = (hd < 4) || (hd == 16) || (hd == 17);
        int fq, bj; if (typeA) { fq = 2 * (d >> 5) + ((d >> 3) & 1); bj = (d >> 4) & 1; } else { fq = (d >> 3) & 3; bj = d >> 5; }
        return 256 * pn + 128 * bj + 32 * wc + 8 * fq + (d & 7);
    } else if (kind == 2) {
        const int bj = n >= FF ? 1 : 0, jh = n - bj * FF;
        return 256 * (jh >> 7) + 128 * bj + (jh & 127);
    }
    return n;
}
__device__ __forceinline__ void transpose_item(const float* W, int K, int N, bf16* WT, int kind, const float* gk, LAS float* scr, int item, int lane) {
    const int nblk = N / 32, kb = item / nblk, nb = item % nblk, k0 = 64 * kb, n0 = 32 * nb;
#pragma unroll 8
    for (int i = 0; i < 32; ++i) { const int kk = 2 * i + (lane >> 5); const float gsc = gk ? gk[k0 + kk] : 1.f; scr[kk * 33 + (lane & 31)] = W[(size_t)(k0 + kk) * N + n0 + (lane & 31)] * gsc; }
    asm volatile("s_waitcnt lgkmcnt(0)" ::: "memory");
    const int c = lane & 7;
#pragma unroll
    for (int j = 0; j < 4; ++j) { const int n = (lane >> 3) + 8 * j; const LAS float* s = scr + (8 * c) * 33 + n;
        v4u o; o.x = pk2h(s[0 * 33], s[1 * 33]); o.y = pk2h(s[2 * 33], s[3 * 33]); o.z = pk2h(s[4 * 33], s[5 * 33]); o.w = pk2h(s[6 * 33], s[7 * 33]);
        *(v4u*)(WT + (size_t)jrow(kind, n0 + n) * K + k0 + 8 * c) = o; }
    asm volatile("s_waitcnt lgkmcnt(0)" ::: "memory");
}

#define XB_TMO      128
#define XB_XCNT(j)  (256  + 64 * (j))
#define XB_XSUB(j)  (1280 + 64 * (j))
#define XB_XGEN(j)  (2304 + 64 * (j))
#define XB_TOP      3328
#define XB_TOPGEN   3392
#define XCD_BAR_WORDS 3456
#define XB_SPIN_CAP (1u << 18)

__device__ __forceinline__ unsigned xb_ld(unsigned* p)              { return __hip_atomic_load(p, __ATOMIC_RELAXED, __HIP_MEMORY_SCOPE_AGENT); }
__device__ __forceinline__ unsigned xb_add(unsigned* p, unsigned v) { return __hip_atomic_fetch_add(p, v, __ATOMIC_RELAXED, __HIP_MEMORY_SCOPE_AGENT); }
__device__ __forceinline__ unsigned xb_xcc_id() { return (unsigned)__builtin_amdgcn_s_getreg((3 << 11) | 20) & 0xFu; }
#define XB_SPIN(cond, bar) do { unsigned _sp = 0; while (cond) { __builtin_amdgcn_s_sleep(1); \
    if ((++_sp & 255u) == 0u) { if (xb_ld(&(bar)[XB_TMO])) break; if (_sp > XB_SPIN_CAP) { atomicAdd(&(bar)[XB_TMO], 1u); break; } } } } while (0)

struct XcdBarrier {
    unsigned* bar; unsigned x;
    volatile LAS unsigned* st;
};

__device__ __forceinline__ XcdBarrier xcd_barrier_post(unsigned* bar, volatile LAS unsigned* st) {
    XcdBarrier b; b.bar = bar; b.x = xb_xcc_id(); b.st = st;
    if (threadIdx.x == 0) (void)xb_add(&bar[XB_XCNT(b.x)], 1u);
    return b;
}
__device__ __forceinline__ void xcd_barrier_complete(unsigned* bar, unsigned x, unsigned& nloc, unsigned& nx) {
    const unsigned G = gridDim.x * gridDim.y * gridDim.z;
    unsigned sum, cnt, mine, sp = 0u;
    for (;;) {
        sum = 0u; cnt = 0u; mine = 0u;
#pragma unroll
        for (unsigned j = 0; j < 16; ++j) { const unsigned c = xb_ld(&bar[XB_XCNT(j)]); sum += c; cnt += (c > 0u) ? 1u : 0u; mine = (j == x) ? c : mine; }
        if (sum == G) break;
        __builtin_amdgcn_s_sleep(1);
        if ((++sp & 255u) == 0u) { if (xb_ld(&bar[XB_TMO])) break; if (sp > XB_SPIN_CAP) { atomicAdd(&bar[XB_TMO], 1u); break; } }
    }
    nloc = mine > 0u ? mine : 1u; nx = cnt > 0u ? cnt : 1u;
}

__device__ __forceinline__ void xcd_barrier(const XcdBarrier& b) {
    asm volatile("s_waitcnt vmcnt(0)" ::: "memory");
    __syncthreads();
    if (threadIdx.x == 0) {
        unsigned* bar = b.bar;
        __builtin_amdgcn_s_waitcnt(0);
        unsigned nloc = b.st[0], nx = b.st[1];
        if (nloc == 0u) { xcd_barrier_complete(bar, b.x, nloc, nx); b.st[0] = nloc; b.st[1] = nx; }
        const unsigned old = xb_add(&bar[XB_XSUB(b.x)], 1u);
        const unsigned gen = old / nloc;
        if (old + 1u == (gen + 1u) * nloc) {
            __builtin_amdgcn_fence(__ATOMIC_RELEASE, "agent");
            asm volatile("s_waitcnt vmcnt(0)" ::: "memory");
            const unsigned og = xb_add(&bar[XB_TOP], 1u);
            const unsigned tg = og / nx;
            if (og + 1u == (tg + 1u) * nx) xb_add(&bar[XB_TOPGEN], 1u);
            else XB_SPIN(xb_ld(&bar[XB_TOPGEN]) == tg, bar);
            __builtin_amdgcn_fence(__ATOMIC_ACQUIRE, "agent");
            xb_add(&bar[XB_XGEN(b.x)], 1u);
            asm volatile("s_waitcnt vmcnt(0)" ::: "memory");
        } else {
            XB_SPIN(xb_ld(&bar[XB_XGEN(b.x)]) == gen, bar);
            __builtin_amdgcn_fence(__ATOMIC_ACQUIRE, "agent");
            asm volatile("s_waitcnt vmcnt(0)" ::: "memory");
        }
    }
    __syncthreads();
}

__global__ void __launch_bounds__(512) fwd_megakernel(Args args) {
    extern __shared__ __attribute__((aligned(16))) unsigned char lds[];
    cg::grid_group grid = cg::this_grid();
    const int tid = threadIdx.x, lane = tid & 63, wave = __builtin_amdgcn_readfirstlane(tid >> 6);
    const int G = gridDim.x, bx = blockIdx.x;
    const int vcu = (G % 8 == 0) ? (bx % 8) * (G / 8) + bx / 8 : bx;
    unsigned char* ws = args.ws;
    const float* x_prompt = args.in[0]; const float* x_sample = args.in[1]; const float* norm_mix = args.in[2]; const float* w_in = args.in[3];
    const float* q_gain = args.in[4]; const float* k_gain = args.in[5]; const float* rpb = args.in[6]; const float* out_gain = args.in[7];
    const float* w_out = args.in[8]; const float* norm_ffn = args.in[9]; const float* w_gate_up = args.in[10]; const float* w_down = args.in[11];
    unsigned* ctl = (unsigned*)(ws + WS_CTL);
    float* cos1 = (float*)(ws + WS_TAB); float* sin1 = cos1 + 4096 * 32; float* cosax = sin1 + 4096 * 32; float* sinax = cosax + 64 * 16;
    typedef unsigned long long u64;
    u64* ssq = (u64*)(ws + WS_SSQ);
    bf16* Wb = (bf16*)(ws + WS_W); bf16* XB = (bf16*)(ws + WS_XB); bf16* QKV = (bf16*)(ws + WS_QKV); bf16* Y = (bf16*)(ws + WS_Y); bf16* H = (bf16*)(ws + WS_H);
    float* out = args.out;
    LAS unsigned char* ldsl = (LAS unsigned char*)lds;
    if (tid < 16) ((LAS unsigned*)(ldsl + MISC_OFF))[tid] = 0u;
    __syncthreads();

#ifndef NO_P0
    {
        const int gw = vcu * 8 + wave, NGW = G * 8, gt = bx * 512 + tid, NGT = G * 512;
        for (int i = gt; i < 8192; i += NGT) ctl[i] = 0u;
        { v4u* z = (v4u*)(ssq + M_TOK); const int nz = 19 * M_TOK / 2; for (int i = gt; i < nz; i += NGT) z[i] = (v4u){0u, 0u, 0u, 0u}; }
        for (int i = gt; i < 4096 * 32 + 64 * 16; i += NGT) {
            int pos, f; float invf;
            if (i < 4096 * 32) { pos = i >> 5; f = i & 31; invf = exp2f(-(float)f * (13.287712379549449f / 32.0f)); }
            else { const int k = i - 4096 * 32; pos = k >> 4; f = k & 15; invf = exp2f(-(float)f * (13.287712379549449f / 16.0f)); }
            const float ang = (float)pos * invf;
            const double rev = (double)ang * 0.15915494309189535; const float fr_ = (float)(rev - __builtin_rint(rev));
            const float cv = __builtin_amdgcn_cosf(fr_), sv = __builtin_amdgcn_sinf(fr_);
            if (i < 4096 * 32) { cos1[i] = cv; sin1[i] = sv; } else { cosax[i - 4096 * 32] = cv; sinax[i - 4096 * 32] = sv; }
        }
        for (int i = gt; i < DEPTH * 384; i += NGT) { const int l_ = i / 384, r_ = i % 384; cos1[264192 + i] = r_ < 192 ? q_gain[l_ * 192 + r_] : k_gain[l_ * 192 + r_ - 192]; }
        if (gw < 12) { const int l_ = gw / 3, mx_ = gw % 3; float a = fabsf(q_gain[l_ * 192 + mx_ * 64 + lane]), b = fabsf(k_gain[l_ * 192 + mx_ * 64 + lane]), c = 0.f;
            if (mx_ == 1) for (int i = lane; i < 6 * 465; i += 64) c = fmaxf(c, fabsf(rpb[(size_t)l_ * 6 * 465 + i]));
#pragma unroll
            for (int o = 1; o < 64; o <<= 1) { a = fmaxf(a, __shfl_xor(a, o)); b = fmaxf(b, __shfl_xor(b, o)); c = fmaxf(c, __shfl_xor(c, o)); }
            if (lane == 0) cos1[BND_OFF + l_ * 4 + mx_] = (8.0f * a * b + c) * 1.4426950408889634f * 1.02f; }
        LAS float* scr = (LAS float*)(ldsl + wave * 16384);
        constexpr int I_IN = 16 * 64, I_OUT = 16 * 32, I_GU = 16 * 176, I_DN = 44 * 32, I_LAYER = I_IN + I_OUT + I_GU + I_DN;
        for (int it = gw; it < DEPTH * I_LAYER; it += NGW) {
            const int l = it / I_LAYER; int r = it % I_LAYER; bf16* Wl = Wb + (size_t)l * W_LAYER;
            if (r < I_IN) { transpose_item(w_in + (size_t)l * DM * QKVW, DM, QKVW, Wl + W_IN, 0, norm_mix + l * DM, scr, r, lane); continue; } r -= I_IN;
            if (r < I_OUT) { transpose_item(w_out + (size_t)l * DM * DM, DM, DM, Wl + W_OUT, 1, out_gain + l * DM, scr, r, lane); continue; } r -= I_OUT;
            if (r < I_GU) { transpose_item(w_gate_up + (size_t)l * DM * 2 * FF, DM, 2 * FF, Wl + W_GU, 2, norm_ffn + l * DM, scr, r, lane); continue; } r -= I_GU;
            transpose_item(w_down + (size_t)l * FF * DM, FF, DM, Wl + W_DOWN, 1, nullptr, scr, r, lane);
        }
        for (int m0 = gw; m0 < M_TOK; m0 += 4 * NGW) {
            f32x4 v[4][4];
#pragma unroll
            for (int r_ = 0; r_ < 4; ++r_) { const int m = m0 + r_ * NGW; if (m < M_TOK) {
                const float* xrow = m < M_PROMPT ? x_prompt + (size_t)m * DM : x_sample + (size_t)(m - M_PROMPT) * DM; const f32x4* xr = (const f32x4*)xrow + lane;
#pragma unroll
                for (int j = 0; j < 4; ++j) v[r_][j] = xr[64 * j]; } }
#pragma unroll
            for (int r_ = 0; r_ < 4; ++r_) { const int m = m0 + r_ * NGW; if (m < M_TOK) {
                float s = 0.f;
#pragma unroll
                for (int j = 0; j < 4; ++j) s += (v[r_][j].x * v[r_][j].x + v[r_][j].y * v[r_][j].y) + (v[r_][j].z * v[r_][j].z + v[r_][j].w * v[r_][j].w);
                s = wave_sum(s);
                unsigned long long* o8 = (unsigned long long*)(XB + (size_t)m * DM) + lane;
#pragma unroll
                for (int j = 0; j < 4; ++j) o8[64 * j] = (unsigned long long)pk2h(v[r_][j].x, v[r_][j].y) | ((unsigned long long)pk2h(v[r_][j].z, v[r_][j].w) << 32);
                if (lane == 0) ssq[m] = (u64)(s * 1073741824.0f); } }
        }
    }
#endif
    grid.sync();
    XcdBarrier xbar = xcd_barrier_post(ctl + 4096, (volatile LAS unsigned*)(ldsl + MISC_OFF));
#define GRID_BAR() xcd_barrier(xbar)

    for (int l = 0; l < DEPTH; ++l) {
        const bf16* Wl = Wb + (size_t)l * W_LAYER;
        int tidl = threadIdx.x; asm volatile("" : "+v"(tidl)); const int lanel = tidl & 63;
        u64* ssq_mix = ssq + (size_t)l * M_TOK; u64* ssq_ffn = ssq + (size_t)(4 + l) * M_TOK;
        u64* ssqA = ssq + (size_t)(8 + l) * M_TOK; u64* ssqB = ssq + (size_t)(12 + l) * M_TOK; u64* ssqC = ssq + (size_t)(16 + l) * M_TOK;
#ifndef NO_P1
        {
            pg8::Gemm g{XB, Wl + W_IN, M_TOK, QKVW, DM}; pg8::StaticOrder S; S.init(M_TOK, QKVW, G, bx);
            pg8::EpiQKV E{QKV, (bf16*)out, ssq_mix, (const float*)(ws + WS_TAB), l, ldsl + 131072};
            pg8::gemm_phase<pg8::EpiQKV, pg8::StaticOrder, PG_ALIGN, PG_SP2>(ldsl, g, S, E);
#ifdef PROBE_P1X2
            __syncthreads();
            pg8::gemm_phase<pg8::EpiQKV, pg8::StaticOrder, PG_ALIGN, PG_SP2>(ldsl, g, S, E);
#endif
        }
#endif
        GRID_BAR();
        {
            LAS float* rpbL = (LAS float*)(ldsl + RPB_OFF);
            const float cA = cos1[BND_OFF + l * 4 + 0], cB = cos1[BND_OFF + l * 4 + 1], cC = cos1[BND_OFF + l * 4 + 2];
            for (int i = tidl; i < 6 * 465; i += 512) rpbL[i] = rpb[(size_t)l * 6 * 465 + i] * 1.4426950408889634f - cB;
            if (tidl == 0) ((volatile LAS unsigned*)(ldsl + MISC_OFF))[4] = 0u;
            __syncthreads();
#ifndef NO_P2A
            const int nA = (G == 256) ? (vcu < 128 ? 2 : 4) : (768 + G - 1 - vcu) / G;
            for (int ia = 0; ia < nA; ++ia) {
                const int u = (G == 256) ? (ia == 0 ? vcu : (vcu < 128 ? 256 + vcu : 256 + 128 + 3 * (vcu - 128) + (ia - 1))) : vcu + ia * G;
                long rowbase; int T, h, kvh, qb;
                if (u < 256) { const int grp = u >> 5, j = u & 31; kvh = grp & 1; rowbase = (long)(grp >> 1) * 4096; T = 4096; h = 2 * kvh + (j >> 4); qb = j & 15; }
                else { const int su = u - 256, grp = su >> 4, j = su & 15; kvh = grp & 1; rowbase = M_PROMPT + (long)(grp >> 1) * 2048; T = 2048; h = 2 * kvh + (j >> 3); qb = j & 7; }
                attn_body::attn_unit<8>(rowbase, T, h, kvh, qb, (const attn_body::bf16*)QKV, (attn_body::bf16*)Y, ssqA, (char*)lds, cA);
#ifdef PROBE_AX2
                attn_body::attn_unit<8>(rowbase, T, h, kvh, qb, (const attn_body::bf16*)QKV, (attn_body::bf16*)Y, (u64*)XB, (char*)lds, cA);
#endif
            }
#endif
#ifndef NO_P2L
            LAS char* vbuf = (LAS char*)(ldsl + 98304 + wave * loc::VBUF_BYTES);
            {
                const bool bal = (G == 256), lowh = vcu < 128;
                const int nC = bal ? (lowh ? 2 : 1) : (384 + G - 1 - vcu) / G, nB = bal ? (lowh ? 1 : 2) : (384 + G - 1 - vcu) / G;
#ifdef PROBE_LOCAL2
                for (int rep = 0; rep < 2; ++rep)
#endif
                for (int k = 0; k < nC + nB; ++k) {
                    const bool isC = k < nC;
                    int uid;
                    if (isC) uid = bal ? (lowh ? 2 * vcu + k : 256 + (vcu - 128)) : vcu + k * G;
                    else uid = bal ? (lowh ? vcu : 128 + 2 * (vcu - 128) + (k - nC)) : vcu + (k - nC) * G;
                    __syncthreads();
                    int lane_o = lanel; asm volatile("" : "+v"(lane_o));
                    const int g0 = isC ? (uid >> 1) * 256 : uid * 128 + wave * 16;
                    long seqrow; int T; if (g0 < M_PROMPT) { T = 4096; seqrow = g0 & ~4095; } else { T = 2048; seqrow = g0 & ~2047; }
                    if (isC) loc::local_unit<2>(QKV, (const bf16*)out, Y, rpbL, vbuf, seqrow, T, (g0 - (int)seqrow) + 8 * (uid & 1) + wave, lane_o, -cC, (LAS char*)ldsl, wave, (g0 - (int)seqrow) + 8 * (uid & 1) - 64);
                    else loc::local_unit_nb(QKV, (const bf16*)out, Y, rpbL, (LAS char*)ldsl, seqrow, T, ((uid * 128) - (int)seqrow) >> 6, wave, lane_o);
                }
            }
#endif
        }
        GRID_BAR();
#ifndef NO_P3
        {
            const int gw = vcu * 8 + wave, NGW = G * 8;
            for (int m0 = 4 * gw; m0 < M_TOK; m0 += 12 * NGW) {
                v4u a[3], b[3]; float sc[3];
#pragma unroll
                for (int j = 0; j < 3; ++j) { const int m = min(m0 + j * 4 * NGW + (lanel >> 4), M_TOK - 1); const v4u* p = (const v4u*)(Y + (size_t)m * DM + 16 * (lanel & 15)); a[j] = p[0]; b[j] = p[1]; sc[j] = (float)ssqA[m] * (1.0f / 1073741824.0f); }
#pragma unroll
                for (int j = 0; j < 3; ++j) { const int m = m0 + j * 4 * NGW + (lanel >> 4); if (m >= M_TOK) continue; const float f = rsqrtf(sc[j] * (1.0f / 256.0f) + 1e-6f); v4u* p = (v4u*)(Y + (size_t)m * DM + 16 * (lanel & 15));
#pragma unroll
                    for (int e = 0; e < 4; ++e) { a[j][e] = pk2h(__uint_as_float(a[j][e] << 16) * f, __uint_as_float(a[j][e] & 0xffff0000u) * f); b[j][e] = pk2h(__uint_as_float(b[j][e] << 16) * f, __uint_as_float(b[j][e] & 0xffff0000u) * f); }
                    p[0] = a[j]; p[1] = b[j]; }
            }
        }
        GRID_BAR();
        {
            pg8::Gemm g{Y, Wl + W_OUT, M_TOK, DM, DM}; pg8::StaticOrder S; S.init(M_TOK, DM, G, bx);
            pg8::EpiRes2<false> E{XB, out, ssq_ffn};
            pg8::gemm_phase<pg8::EpiRes2<false>, pg8::StaticOrder, PG_ALIGN, PG_SP2>(ldsl, g, S, E);
        }
#endif
        GRID_BAR();
#ifndef NO_P4
        {
            pg8::Gemm g{XB, Wl + W_GU, M_TOK, 2 * FF, DM}; pg8::StaticOrder S; S.init(M_TOK, 2 * FF, G, bx);
            pg8::EpiGU E{H, ssq_ffn, ldsl + 131072};
            pg8::gemm_phase<pg8::EpiGU, pg8::StaticOrder, PG_ALIGN, PG_SP2>(ldsl, g, S, E);
#ifdef PROBE_P4X2
            __syncthreads();
            pg8::gemm_phase<pg8::EpiGU, pg8::StaticOrder, PG_ALIGN, PG_SP2>(ldsl, g, S, E);
#endif
        }
#endif
        GRID_BAR();
#ifndef NO_P5
        {
            pg8::Gemm g{H, Wl + W_DOWN, M_TOK, DM, FF}; pg8::StaticOrder S; S.init(M_TOK, DM, G, bx);
            if (l + 1 < DEPTH) { pg8::EpiRes2<false> E{XB, out, ssq + (size_t)(l + 1) * M_TOK}; pg8::gemm_phase<pg8::EpiRes2<false>, pg8::StaticOrder, PG_ALIGN, PG_SP2>(ldsl, g, S, E); }
            else { pg8::EpiRes2<true> E{XB, out, nullptr}; pg8::gemm_phase<pg8::EpiRes2<true>, pg8::StaticOrder, PG_ALIGN, PG_SP2>(ldsl, g, S, E); }
        }
#endif
        if (l + 1 < DEPTH) GRID_BAR();
    }
}

extern "C" void kernel_launch(void* const* d_in, const int* in_sizes, int n_in, void* d_out, int out_size, void* d_ws, size_t ws_size, hipStream_t stream) {
    static int grid_blocks = 0;
    if (grid_blocks == 0) {
        if (n_in != 12 || out_size != M_TOK * DM || ws_size < WS_END) { fprintf(stderr, "kernel_launch: unexpected shapes (n_in %d out %d ws %zu)\n", n_in, out_size, ws_size); grid_blocks = -1; return; }
        int dev = 0, cus = 0, per_cu = 0;
        hipGetDevice(&dev); hipDeviceGetAttribute(&cus, hipDeviceAttributeMultiprocessorCount, dev);
        hipFuncSetAttribute((const void*)fwd_megakernel, hipFuncAttributeMaxDynamicSharedMemorySize, LDS_BYTES);
        hipOccupancyMaxActiveBlocksPerMultiprocessor(&per_cu, (const void*)fwd_megakernel, 512, LDS_BYTES);
        if (per_cu < 1) { fprintf(stderr, "kernel_launch: occupancy query says %d blocks per CU\n", per_cu); per_cu = 1; }
        grid_blocks = cus * 1;
    }
    if (grid_blocks < 0) return;
    Args a{};
    for (int i = 0; i < 12; ++i) a.in[i] = (const float*)d_in[i];
    a.out = (float*)d_out; a.ws = (unsigned char*)d_ws;
    void* kargs[] = {&a};
    hipError_t e = hipLaunchCooperativeKernel((const void*)fwd_megakernel, dim3(grid_blocks), dim3(512), kargs, LDS_BYTES, stream);
    if (e != hipSuccess) fprintf(stderr, "cooperative launch failed: %s (grid %d)\n", hipGetErrorString(e), grid_blocks);
}
```

```cpp
#include <hip/hip_runtime.h>
#include <cstdio>
#include <cstdint>
namespace pg8 {
#define PG8_LAS __attribute__((address_space(3)))
typedef unsigned short bf16_t;
typedef short bf16x8 __attribute__((ext_vector_type(8)));
typedef float f32x4 __attribute__((ext_vector_type(4)));
typedef unsigned u32x4 __attribute__((ext_vector_type(4)));
constexpr int BM = 256, BK = 64, HALF = 128, HTB = HALF * BK * 2  , STAGE_BYTES = 8 * HTB, NXCD = 8, WGM = 8;

__host__ __device__ __forceinline__ int lds_byte(int r, int c) { const int st = (r >> 4) * 2 + (c >> 5), rr = r & 15, cc = c & 31, ob = rr * 64 + cc * 2; return st * 1024 + (ob ^ (((ob >> 9) & 1) << 5)); }
__host__ __device__ __forceinline__ void stage_rc(int b, int& R, int& C) { const int st = b / 1024, sb = b % 1024, swz = sb ^ (((sb >> 9) & 1) << 5); R = (st >> 1) * 16 + swz / 64; C = (st & 1) * 32 + (swz % 64) / 2; }
__host__ __device__ __forceinline__ int perm32(int rho) { const int n = rho >> 4, i = rho & 15; return 8 * (i >> 2) + 4 * n + (i & 3); }

struct Unit { int pm, pn; };
struct Gemm { const bf16_t* A; const bf16_t* Bt; int M, N, K; };

struct StaticOrder {
    int nM, nN, nwg, G, c;
    __host__ __device__ void init(int M, int N, int G_, int c_) { nM = M / BM; nN = N / BM; nwg = nM * nN; G = G_; c = c_; }
    __host__ __device__ bool next(int i, Unit& u) const {
        const long L = (long)i * G + c; if (L >= nwg) return false;
        int wgid = (int)L; { const int q = nwg / NXCD, r = nwg % NXCD, xcd = wgid % NXCD, off = wgid / NXCD; wgid = (xcd < r ? xcd * (q + 1) : r * (q + 1) + (xcd - r) * q) + off; }
        const int nig = WGM * nN, gid = wgid / nig, fm = gid * WGM, gsz = (nM - fm) < WGM ? (nM - fm) : WGM;
        u.pm = fm + ((wgid % nig) % gsz); u.pn = (wgid % nig) / gsz; return true;
    }
    __device__ __forceinline__ void a_ready(const Unit&) const {}
    __device__ __forceinline__ void done(const Unit&) const {}
};

__device__ __forceinline__ unsigned cvt_pk_bf16(float lo, float hi) { unsigned r; asm volatile("v_cvt_pk_bf16_f32 %0, %1, %2" : "=v"(r) : "v"(lo), "v"(hi)); return r; }
typedef float f32x2 __attribute__((ext_vector_type(2)));
constexpr float RMS_EPS = 1e-6f;
typedef unsigned long long u64;
__device__ __forceinline__ void ssq_add(u64* p, float v) { atomicAdd(p, (u64)(v * 1073741824.0f)); }
__device__ __forceinline__ float ssq_get(const u64* p) { return (float)(*p) * (1.0f / 1073741824.0f); }
constexpr float QSCALE = 0.125f * 1.4426950408889634f;
__device__ __forceinline__ int seq_pos(int row) { return row < 16384 ? (row & 4095) : (row & 2047); }
__device__ __forceinline__ u32x4 pack8(const f32x4 a, const f32x4 b) { u32x4 w; w.x = cvt_pk_bf16(a[0], a[1]); w.y = cvt_pk_bf16(a[2], a[3]); w.z = cvt_pk_bf16(b[0], b[1]); w.w = cvt_pk_bf16(b[2], b[3]); return w; }

struct EpiQKV {
    static constexpr bool PERM = true, AFTER_DRAIN = false, KHOOK = false, SSQ_LDS = true;
    bf16_t* QKV; bf16_t* KVC; const u64* ssq; const float* tab; int layer; PG8_LAS unsigned char* stab;
    __device__ __forceinline__ void prefetch(const Unit& u, int ui, int wid, int lane) const {
        __builtin_amdgcn_global_load_lds((const unsigned*)(ssq + (size_t)u.pm * BM) + wid * 64 + lane, (PG8_LAS unsigned*)(stab + (ui & 1) * 2048 + wid * 256), 4, 0, 0); }
    __device__ __forceinline__ void epi(const f32x4 (&acc)[2][2][4][2], const Unit& u, int wr, int wc, int fr, int fq, int ui) const {
        const int hd = u.pn * 4 + wc;
        int kind, mixer;
        if (hd < 16) { kind = 0; mixer = hd < 4 ? 0 : (hd < 10 ? 1 : 2); }
        else if (hd < 24) { kind = 1; const int kh = hd - 16; mixer = kh < 2 ? 0 : (kh < 5 ? 1 : 2); }
        else { kind = 2; mixer = 1; }
        const bool typeA = (kind != 2) && (mixer == 0);
        const int db0 = typeA ? (32 * (fq >> 1) + 8 * (fq & 1)) : 8 * fq;
        const int dstep = typeA ? 16 : 32;
        const float* cos1 = tab; const float* sin1 = tab + 131072; const float* cosax = tab + 262144; const float* sinax = tab + 263168;
        const float* gp = tab + 264192 + layer * 384 + (kind == 1 ? 192 : 0) + mixer * 64 + db0;
        const float qs = (kind == 0) ? QSCALE : 1.f;
        const bool rope = (kind != 2) && (mixer != 1);
        const int row0 = u.pm * BM + wr * 64 + fr;
        float rr[8];
#pragma unroll
        for (int i = 0; i < 8; ++i) rr[i] = (float)(*(const PG8_LAS u64*)(stab + (ui & 1) * 2048 + (wr * 64 + fr + (i >> 2) * HALF + (i & 3) * 16) * 8)) * (1.0f / 1073741824.0f);
        f32x4 gn[2][2];
#pragma unroll
        for (int bj = 0; bj < 2; ++bj)
#pragma unroll
            for (int n = 0; n < 2; ++n) gn[bj][n] = (kind != 2) ? *(const f32x4*)(gp + bj * dstep + 4 * n) : (f32x4){1.f, 1.f, 1.f, 1.f};
        f32x4 cn[2], sn[2];
#define QKV_TAB(i_) do { if (rope) { const int t_ = seq_pos(row0 + ((i_) >> 2) * HALF + ((i_) & 3) * 16); const float* cp_; const float* sp_; \
            if (mixer == 0) { const int pos_ = (fq >> 1) ? (t_ & 63) : (t_ >> 6); cp_ = cosax + pos_ * 16 + 8 * (fq & 1); sp_ = sinax + pos_ * 16 + 8 * (fq & 1); } \
            else { cp_ = cos1 + t_ * 32 + 8 * fq; sp_ = sin1 + t_ * 32 + 8 * fq; } \
            cn[0] = *(const f32x4*)cp_; cn[1] = *(const f32x4*)(cp_ + 4); sn[0] = *(const f32x4*)sp_; sn[1] = *(const f32x4*)(sp_ + 4); } } while (0)
        QKV_TAB(0);
#pragma unroll
        for (int i = 0; i < 8; ++i) {
            const int ai = i >> 2, m = i & 3;
            const int row = row0 + ai * HALF + m * 16;
            const f32x4 c0 = cn[0], c1 = cn[1], s0 = sn[0], s1 = sn[1];
            if (i + 1 < 8) QKV_TAB(i + 1);
            const float r = rsqrtf(rr[i] * (1.0f / 1024.0f) + RMS_EPS);
            f32x4 v[2][2];
#pragma unroll
            for (int bj = 0; bj < 2; ++bj)
#pragma unroll
                for (int n = 0; n < 2; ++n) v[bj][n] = acc[ai][bj][m][n] * r;
            if (kind != 2) {
                float ss = 0.f;
#pragma unroll
                for (int bj = 0; bj < 2; ++bj)
#pragma unroll
                    for (int n = 0; n < 2; ++n) { const f32x4 x = v[bj][n]; ss += (x[0] * x[0] + x[1] * x[1]) + (x[2] * x[2] + x[3] * x[3]); }
                ss += __shfl_xor(ss, 16); ss += __shfl_xor(ss, 32);
                const float rn = rsqrtf(ss * (1.0f / 64.0f) + RMS_EPS);
#pragma unroll
                for (int bj = 0; bj < 2; ++bj)
#pragma unroll
                    for (int n = 0; n < 2; ++n) v[bj][n] = v[bj][n] * rn * gn[bj][n];
                if (rope) {
                    { const f32x4 x1 = v[0][0], x2 = v[1][0]; v[0][0] = x1 * c0 - x2 * s0; v[1][0] = x2 * c0 + x1 * s0; }
                    { const f32x4 x1 = v[0][1], x2 = v[1][1]; v[0][1] = x1 * c1 - x2 * s1; v[1][1] = x2 * c1 + x1 * s1; }
                }
#pragma unroll
                for (int bj = 0; bj < 2; ++bj)
#pragma unroll
                    for (int n = 0; n < 2; ++n) v[bj][n] = v[bj][n] * qs;
            }
            bf16_t* rowp = QKV + (size_t)row * 2048 + hd * 64 + db0;
            if (hd >= 18 && hd < 24) rowp = KVC + ((size_t)(hd - 18) * 49152 + row) * 128 + db0;
            else if (hd >= 26) rowp = KVC + ((size_t)(hd - 26) * 49152 + row) * 128 + 64 + db0;
#pragma unroll
            for (int bj = 0; bj < 2; ++bj) *(u32x4*)(rowp + bj * dstep) = pack8(v[bj][0], v[bj][1]);
            asm volatile("" ::: "memory");
        }
#undef QKV_TAB
    }
};

struct EpiGU {
    static constexpr bool PERM = true, AFTER_DRAIN = false, KHOOK = false, SSQ_LDS = true;
    bf16_t* H; const u64* ssq; PG8_LAS unsigned char* stab;
    __device__ __forceinline__ void prefetch(const Unit& u, int ui, int wid, int lane) const {
        __builtin_amdgcn_global_load_lds((const unsigned*)(ssq + (size_t)u.pm * BM) + wid * 64 + lane, (PG8_LAS unsigned*)(stab + (ui & 1) * 2048 + wid * 256), 4, 0, 0); }
    __device__ __forceinline__ void epi(const f32x4 (&acc)[2][2][4][2], const Unit& u, int wr, int wc, int fr, int fq, int ui) const {
        const int col0 = u.pn * HALF + wc * 32 + 8 * fq;
#pragma unroll
        for (int ai = 0; ai < 2; ++ai)
#pragma unroll
            for (int m = 0; m < 4; ++m) {
                const int row = u.pm * BM + ai * HALF + wr * 64 + m * 16 + fr;
                const float r = rsqrtf((float)(*(const PG8_LAS u64*)(stab + (ui & 1) * 2048 + (ai * HALF + wr * 64 + m * 16 + fr) * 8)) * (1.0f / 1073741824.0f) * (1.0f / 1024.0f) + RMS_EPS);
                f32x4 h[2];
#pragma unroll
                for (int n = 0; n < 2; ++n) {
                    const f32x4 g = acc[ai][0][m][n] * r, uu = acc[ai][1][m][n] * r;
#pragma unroll
                    for (int e = 0; e < 4; ++e) { const float sg = __builtin_amdgcn_rcpf(1.0f + __builtin_amdgcn_exp2f(-1.4426950408889634f * g[e])); h[n][e] = g[e] * sg * uu[e]; }
                }
                __builtin_nontemporal_store(pack8(h[0], h[1]), (u32x4*)(H + (size_t)row * 2816 + col0));
            }
    }
};

template <bool LAST> struct EpiRes2 {
    static constexpr bool PERM = true, AFTER_DRAIN = false, KHOOK = false, SSQ_LDS = false;
    bf16_t* XB; float* out; u64* ssq_next;
    __device__ __forceinline__ void operator()(const f32x4 (&acc)[2][2][4][2], const Unit& u, int wr, int wc, int fr, int fq) const {
        const int col0 = u.pn * BM + wc * 32 + 8 * fq;
        const int row0 = u.pm * BM + wr * 64 + fr;
        u32x4 w[8][2];
#pragma unroll
        for (int i = 0; i < 8; ++i)
#pragma unroll
            for (int bj = 0; bj < 2; ++bj) w[i][bj] = *(const u32x4*)(XB + (size_t)(row0 + (i >> 2) * HALF + (i & 3) * 16) * 1024 + col0 + bj * HALF);
#pragma unroll
        for (int i = 0; i < 8; ++i) {
            const int ai = i >> 2, m = i & 3;
            const int row = row0 + ai * HALF + m * 16;
            float ss = 0.f;
#pragma unroll
            for (int bj = 0; bj < 2; ++bj) {
                f32x4 x[2];
#pragma unroll
                for (int n = 0; n < 2; ++n) { const unsigned lo = w[i][bj][2 * n], hi = w[i][bj][2 * n + 1];
                    const f32x4 bs = (f32x4){__uint_as_float(lo << 16), __uint_as_float(lo & 0xffff0000u), __uint_as_float(hi << 16), __uint_as_float(hi & 0xffff0000u)};
                    x[n] = bs + acc[ai][bj][m][n]; ss += (x[n][0] * x[n][0] + x[n][1] * x[n][1]) + (x[n][2] * x[n][2] + x[n][3] * x[n][3]); }
                if (LAST) { float* op = out + (size_t)row * 1024 + col0 + bj * HALF; *(f32x4*)op = x[0]; *(f32x4*)(op + 4) = x[1]; }
                else *(u32x4*)(XB + (size_t)row * 1024 + col0 + bj * HALF) = pack8(x[0], x[1]);
            }
            if (!LAST) { ss += __shfl_xor(ss, 16); ss += __shfl_xor(ss, 32); if (fq == 0) ssq_add(ssq_next + row, ss); }
        }
    }
};
template <class Epi, class Sched, bool ALIGN_EPI = false, bool SP2 = false>
__device__ __forceinline__ void gemm_phase(PG8_LAS unsigned char* lds, const Gemm g, const Sched& S, const Epi& E) {
    int tid_ = threadIdx.x; asm volatile("" : "+v"(tid_));
    const int tid = tid_, wid = __builtin_amdgcn_readfirstlane(tid >> 6), lane = tid & 63, wr = wid >> 2, wc = wid & 3, fr = lane & 15, fq = lane >> 4;
    const int K = g.K, nt = K / BK;
    unsigned voffA[2], voffB[2];
#pragma unroll
    for (int i = 0; i < 2; ++i) { int R, C; stage_rc(tid * 16 + i * 8192, R, C); const int Rb = Epi::PERM ? ((R & ~31) + perm32(R & 31)) : R;
        voffA[i] = (unsigned)(R * K + C) * 2u; voffB[i] = (unsigned)(Rb * K + C) * 2u; }
    const size_t kstep = (size_t)(BK * 2);
    const size_t hstep = (size_t)HALF * K * 2;
    const size_t tstep = 2 * hstep;
    const unsigned ldsw = (unsigned)wid * 1024u;
    const int aoff = lds_byte(wr * 64 + fr, fq * 8), boff = lds_byte(wc * 32 + fr, fq * 8);
#define PG8_SA(b, h) (((b) * 2 + (h)) * HTB)
#define PG8_SB(b, h) ((4 + (b) * 2 + (h)) * HTB)
#define PG8_STAGE(bufoff, gbase, voff) do { _Pragma("unroll") for (int _i = 0; _i < 2; ++_i) \
        __builtin_amdgcn_global_load_lds((const unsigned*)((const char*)(gbase) + (voff)[_i]), (PG8_LAS unsigned*)(lds + (bufoff) + ldsw + _i * 8192), 16, 0, 0); } while (0)
#define PG8_LDA(dst, b, h) do { _Pragma("unroll") for (int m = 0; m < 4; ++m) _Pragma("unroll") for (int k = 0; k < 2; ++k) dst[m][k] = *(const PG8_LAS bf16x8*)(lds + PG8_SA(b, h) + aoff + m * 2048 + k * 1024); } while (0)
#define PG8_LDB(dst, b, h) do { _Pragma("unroll") for (int n = 0; n < 2; ++n) _Pragma("unroll") for (int k = 0; k < 2; ++k) dst[n][k] = *(const PG8_LAS bf16x8*)(lds + PG8_SB(b, h) + boff + n * 2048 + k * 1024); } while (0)
#define PG8_MMA(ai, bj, At, Bt) do { __builtin_amdgcn_s_setprio(1); _Pragma("unroll") for (int m = 0; m < 4; ++m) _Pragma("unroll") for (int n = 0; n < 2; ++n) _Pragma("unroll") for (int k = 0; k < 2; ++k) \
        acc[ai][bj][m][n] = __builtin_amdgcn_mfma_f32_16x16x32_bf16(Bt[n][k], At[m][k], acc[ai][bj][m][n], 0, 0, 0); __builtin_amdgcn_s_setprio(0); } while (0)
#define PG8_WAIT_V(n) asm volatile("s_waitcnt vmcnt(" #n ")" ::: "memory")
#define PG8_WAIT_L(n) asm volatile("s_waitcnt lgkmcnt(" #n ")" ::: "memory")
#define PG8_BAR __builtin_amdgcn_s_barrier()
#define PG8_SCHED __builtin_amdgcn_sched_barrier(0)
    Unit cur, nxt; int ui = 0;
    if (!S.next(0, cur)) return;
    f32x4 acc[2][2][4][2];
#pragma unroll
    for (int a = 0; a < 2; ++a)
#pragma unroll
        for (int b = 0; b < 2; ++b)
#pragma unroll
            for (int m = 0; m < 4; ++m)
#pragma unroll
                for (int n = 0; n < 2; ++n) acc[a][b][m][n] = (f32x4){0.f, 0.f, 0.f, 0.f};
    bf16x8 At[4][2], B0[2][2], B1[2][2];
    const char* cA = (const char*)g.A + (size_t)cur.pm * tstep; const char* cB = (const char*)g.Bt + (size_t)cur.pn * tstep;
    S.a_ready(cur);
    if constexpr (SP2) {
        PG8_STAGE(PG8_SB(0, 0), cB, voffB); PG8_STAGE(PG8_SB(0, 1), cB + hstep, voffB); PG8_STAGE(PG8_SA(0, 0), cA, voffA); PG8_STAGE(PG8_SA(0, 1), cA + hstep, voffA);
        if (wr == 1) PG8_BAR;
        PG8_WAIT_V(2); PG8_BAR;
        PG8_STAGE(PG8_SB(1, 0), cB + kstep, voffB); PG8_STAGE(PG8_SA(1, 0), cA + kstep, voffA); PG8_STAGE(PG8_SB(1, 1), cB + hstep + kstep, voffB);
        PG8_WAIT_V(6); PG8_BAR;
    } else {
        PG8_STAGE(PG8_SB(0, 0), cB, voffB); PG8_STAGE(PG8_SA(0, 0), cA, voffA); PG8_STAGE(PG8_SB(0, 1), cB + hstep, voffB); PG8_STAGE(PG8_SA(0, 1), cA + hstep, voffA);
        if (wr == 1) PG8_BAR;
        PG8_WAIT_V(4); PG8_BAR;
        PG8_STAGE(PG8_SB(1, 0), cB + kstep, voffB); PG8_STAGE(PG8_SA(1, 0), cA + kstep, voffA); PG8_STAGE(PG8_SB(1, 1), cB + hstep + kstep, voffB);
        PG8_WAIT_V(6); PG8_BAR;
    }
    for (;;) {
        const bool has_next = S.next(ui + 1, nxt);
        if constexpr (Epi::SSQ_LDS) E.prefetch(cur, ui, wid, lane);
        const char* nA = has_next ? (const char*)g.A + (size_t)nxt.pm * tstep : cA; const char* nB = has_next ? (const char*)g.Bt + (size_t)nxt.pn * tstep : cB;
        for (int t = 0; t < nt; t += 2) {
            const bool last = (t == nt - 2);
            if constexpr (Epi::KHOOK) { if (t == 4 || t == 10) { PG8_SCHED; asm volatile("" ::: "memory"); E.khook(acc, cur, wr, fr, t == 4 ? 0 : 1); asm volatile("" ::: "memory"); PG8_SCHED; } }
            const char* a1 = cA + (size_t)(t + 1) * kstep;
            const char* a2 = last ? nA : cA + (size_t)(t + 2) * kstep; const char* b2 = last ? nB : cB + (size_t)(t + 2) * kstep;
            const char* a3 = a2 + kstep; const char* b3 = b2 + kstep;
            if (last && has_next) S.a_ready(nxt);
            if constexpr (SP2) {
            PG8_LDB(B0, 0, 0); PG8_LDB(B1, 0, 1); PG8_SCHED; PG8_LDA(At, 0, 0); PG8_STAGE(PG8_SA(1, 1), a1 + hstep, voffA);
            PG8_WAIT_V(8); PG8_WAIT_L(0); PG8_BAR; PG8_MMA(0, 0, At, B0); PG8_MMA(0, 1, At, B1); PG8_BAR; PG8_SCHED;
            PG8_LDA(At, 0, 1); PG8_STAGE(PG8_SB(0, 0), b2, voffB); PG8_STAGE(PG8_SB(0, 1), b2 + hstep, voffB); PG8_STAGE(PG8_SA(0, 0), a2, voffA);
            PG8_WAIT_V(8); PG8_WAIT_L(0); PG8_BAR; PG8_MMA(1, 0, At, B0); PG8_MMA(1, 1, At, B1); PG8_BAR; PG8_SCHED;
            PG8_LDB(B0, 1, 0); PG8_LDB(B1, 1, 1); PG8_SCHED; PG8_LDA(At, 1, 0); PG8_STAGE(PG8_SA(0, 1), a2 + hstep, voffA);
            PG8_WAIT_V(8); PG8_WAIT_L(0); PG8_BAR; PG8_MMA(0, 0, At, B0); PG8_MMA(0, 1, At, B1); PG8_BAR; PG8_SCHED;
            PG8_LDA(At, 1, 1); PG8_STAGE(PG8_SB(1, 0), b3, voffB); PG8_STAGE(PG8_SB(1, 1), b3 + hstep, voffB); PG8_STAGE(PG8_SA(1, 0), a3, voffA);
            PG8_WAIT_V(8); PG8_WAIT_L(0); PG8_BAR; PG8_MMA(1, 0, At, B0); PG8_MMA(1, 1, At, B1); PG8_BAR; PG8_SCHED;
            } else {
            PG8_LDB(B0, 0, 0); PG8_SCHED; PG8_LDA(At, 0, 0); PG8_STAGE(PG8_SA(1, 1), a1 + hstep, voffA);
            PG8_WAIT_L(8); PG8_BAR; PG8_WAIT_L(0); PG8_MMA(0, 0, At, B0); PG8_BAR; PG8_SCHED;
            PG8_LDB(B1, 0, 1); PG8_STAGE(PG8_SB(0, 0), b2, voffB);
            PG8_BAR; PG8_WAIT_L(0); PG8_MMA(0, 1, At, B1); PG8_BAR;
            PG8_LDA(At, 0, 1); PG8_STAGE(PG8_SA(0, 0), a2, voffA);
            PG8_BAR; PG8_WAIT_L(0); PG8_MMA(1, 0, At, B0); PG8_BAR; PG8_SCHED;
            PG8_STAGE(PG8_SB(0, 1), b2 + hstep, voffB);
            PG8_WAIT_V(6); PG8_BAR; PG8_MMA(1, 1, At, B1); PG8_BAR;
            PG8_LDB(B0, 1, 0); PG8_SCHED; PG8_LDA(At, 1, 0); PG8_STAGE(PG8_SA(0, 1), a2 + hstep, voffA);
            PG8_WAIT_L(8); PG8_BAR; PG8_WAIT_L(0); PG8_MMA(0, 0, At, B0); PG8_BAR; PG8_SCHED;
            PG8_LDB(B1, 1, 1); PG8_STAGE(PG8_SB(1, 0), b3, voffB);
            PG8_BAR; PG8_WAIT_L(0); PG8_MMA(0, 1, At, B1); PG8_BAR;
            PG8_LDA(At, 1, 1); PG8_STAGE(PG8_SA(1, 0), a3, voffA);
            PG8_BAR; PG8_WAIT_L(0); PG8_MMA(1, 0, At, B0); PG8_BAR; PG8_SCHED;
            PG8_STAGE(PG8_SB(1, 1), b3 + hstep, voffB);
            PG8_WAIT_V(6); PG8_BAR; PG8_MMA(1, 1, At, B1); PG8_BAR;
            }
        }
        if constexpr (ALIGN_EPI) { if (wr == 0) PG8_BAR; }
        if constexpr (!Epi::AFTER_DRAIN) { if constexpr (Epi::SSQ_LDS) E.epi(acc, cur, wr, wc, fr, fq, ui); else E(acc, cur, wr, wc, fr, fq); S.done(cur); }
        if (!has_next) break;
#pragma unroll
        for (int a = 0; a < 2; ++a)
#pragma unroll
            for (int b = 0; b < 2; ++b)
#pragma unroll
                for (int m = 0; m < 4; ++m)
#pragma unroll
                    for (int n = 0; n < 2; ++n) acc[a][b][m][n] = (f32x4){0.f, 0.f, 0.f, 0.f};
        cur = nxt; cA = nA; cB = nB; ++ui;
        if constexpr (ALIGN_EPI) { if (wr == 1) PG8_BAR; }
    }
    PG8_WAIT_V(0);
    if constexpr (!ALIGN_EPI) { if (wr == 0) PG8_BAR; }
    PG8_BAR;
    if constexpr (Epi::AFTER_DRAIN) { E.fused(acc, cur, wr, wc, fr, fq, lds, wid, lane); S.done(cur); }
#undef PG8_SA
#undef PG8_SB
#undef PG8_STAGE
#undef PG8_LDA
#undef PG8_LDB
#undef PG8_MMA
#undef PG8_WAIT_V
#undef PG8_WAIT_L
#undef PG8_BAR
#undef PG8_SCHED
}
}
#include <hip/hip_bf16.h>
#include <cmath>
namespace attn_body {
using bf16=__hip_bfloat16;
using bf16x8=__attribute__((ext_vector_type(8)))short;
using s16x4=__attribute__((ext_vector_type(4)))short;
using f32x16=__attribute__((ext_vector_type(16)))float;
using u32x4=__attribute__((ext_vector_type(4)))unsigned;
constexpr int D=64,QP=2048,OP=1024;
constexpr int NW=8,QBLK=32,QB=QBLK*NW,KVBLK=64;

__device__ __forceinline__ int crow(int r,int hi){return (r&3)+8*(r>>2)+4*hi;}
#define SBAR() __builtin_amdgcn_sched_barrier(0)
__device__ __forceinline__ void cmask(f32x16&p0,f32x16&p1,int jb,int qrel,int hi){
  const float NEG=-INFINITY; int kb=64*jb+4*hi;
  #pragma unroll
  for(int r=0;r<16;++r){int kv=kb+(r&3)+8*(r>>2); if(kv>qrel)p0[r]=NEG; if(kv+32>qrel)p1[r]=NEG;}
}

constexpr int NSLOT=3, SLOTB=8192;
constexpr int LDS_K=0, LDS_V=NSLOT*SLOTB, LDS_WS=2*NSLOT*SLOTB, LDS_OST=LDS_WS+NW*64*4, LDS_BYTES=LDS_OST+NW*4096;
constexpr float C2=0.125f*1.4426950408889634f;
__device__ __forceinline__ void glds16(const void*gsrc,unsigned lds_dst){unsigned keep;
  asm volatile("s_mov_b32 %0, m0\n\ts_mov_b32 m0, %2\n\ts_nop 0\n\tglobal_load_lds_dwordx4 %1, off\n\ts_mov_b32 m0, %0":"=&s"(keep):"v"(gsrc),"s"(lds_dst):"memory");}
__device__ __forceinline__ float max3f(float a,float b,float c){float r;asm("v_max3_f32 %0, %1, %2, %3":"=v"(r):"v"(a),"v"(b),"v"(c));return r;}
__device__ __forceinline__ float max2f(float a,float b){float r;asm("v_max_f32_e32 %0, %1, %2":"=v"(r):"v"(a),"v"(b));return r;}
__device__ __forceinline__ float fadd_s(float a,float b){float r;asm("v_add_f32_e32 %0, %1, %2":"=v"(r):"v"(a),"v"(b));return r;}
__device__ __forceinline__ float fsub_s(float a,float b){float r;asm("v_sub_f32_e32 %0, %1, %2":"=v"(r):"v"(a),"v"(b));return r;}
typedef float f32x2_t __attribute__((ext_vector_type(2))); typedef __bf16 bf16x2_t __attribute__((ext_vector_type(2)));
__device__ __forceinline__ unsigned cvtpk_s(float lo,float hi){f32x2_t v={lo,hi};bf16x2_t b=__builtin_convertvector(v,bf16x2_t);return __builtin_bit_cast(unsigned,b);}
#define WAIT_BAR(N) asm volatile("s_waitcnt vmcnt(" #N ") lgkmcnt(0)\n\ts_barrier":::"memory")

__device__ __forceinline__ void qkt(f32x16&p0,f32x16&p1,const char*Kslot,const bf16x8*qr,const f32x16&negm,int r32,int hi){
  const char*kb=Kslot+hi*1024+r32*16;
  #pragma unroll
  for(int d0=0;d0<4;++d0){
    const bf16x8 b0=*reinterpret_cast<const bf16x8*>(kb+d0*2048);
    const bf16x8 b1=*reinterpret_cast<const bf16x8*>(kb+d0*2048+512);
    if(d0==0){p0=__builtin_amdgcn_mfma_f32_32x32x16_bf16(b0,qr[0],negm,0,0,0);p1=__builtin_amdgcn_mfma_f32_32x32x16_bf16(b1,qr[0],negm,0,0,0);}
    else{p0=__builtin_amdgcn_mfma_f32_32x32x16_bf16(b0,qr[d0],p0,0,0,0);p1=__builtin_amdgcn_mfma_f32_32x32x16_bf16(b1,qr[d0],p1,0,0,0);}}
}
typedef __attribute__((address_space(3))) const char* lds_cptr;
typedef short v4i16_t __attribute__((ext_vector_type(4)));
__device__ __forceinline__ void kload8(bf16x8*kf,lds_cptr kp){
  kf[0]=*(const __attribute__((address_space(3))) bf16x8*)(kp);      kf[1]=*(const __attribute__((address_space(3))) bf16x8*)(kp+512);
  kf[2]=*(const __attribute__((address_space(3))) bf16x8*)(kp+2048); kf[3]=*(const __attribute__((address_space(3))) bf16x8*)(kp+2560);
  kf[4]=*(const __attribute__((address_space(3))) bf16x8*)(kp+4096); kf[5]=*(const __attribute__((address_space(3))) bf16x8*)(kp+4608);
  kf[6]=*(const __attribute__((address_space(3))) bf16x8*)(kp+6144); kf[7]=*(const __attribute__((address_space(3))) bf16x8*)(kp+6656);
}
__device__ __forceinline__ void kload2(bf16x8*kf,lds_cptr kp,int j){ kf[2*j]=*(const __attribute__((address_space(3))) bf16x8*)(kp+j*2048); kf[2*j+1]=*(const __attribute__((address_space(3))) bf16x8*)(kp+j*2048+512); }
__device__ __forceinline__ s16x4 vtr(lds_cptr p){ return __builtin_bit_cast(s16x4,__builtin_amdgcn_ds_read_tr16_b64_v4i16((__attribute__((address_space(3))) v4i16_t*)p)); }
__device__ __forceinline__ float rowmax(const f32x16&p0,const f32x16&p1){
  float a=max3f(p0[0],p0[1],p1[0]),b=max3f(p0[2],p0[3],p1[1]);a=max3f(a,p1[2],p1[3]);
  #pragma unroll
  for(int r=4;r<16;r+=4){a=max3f(a,p0[r],p0[r+1]);b=max3f(b,p0[r+2],p0[r+3]);a=max3f(a,p1[r],p1[r+1]);b=max3f(b,p1[r+2],p1[r+3]);}
  const float m=max2f(a,b);
  auto rr=__builtin_amdgcn_permlane32_swap(__float_as_uint(m),__float_as_uint(m),false,false);
  return max2f(__uint_as_float(rr[0]),__uint_as_float(rr[1]));
}
__device__ __forceinline__ void pv(f32x16*o,int vb,bf16x8 pa0,bf16x8 pa1,bf16x8 pa2,bf16x8 pa3){
  #pragma unroll
  for(int d0=0;d0<2;++d0){s16x4 lo[4],hi[4];
    #pragma unroll
    for(int ks=0;ks<4;++ks){
      asm volatile("ds_read_b64_tr_b16 %0,%1 offset:%c2":"=&v"(lo[ks]):"v"(vb),"i"(d0*4096+ks*1024):"memory");
      asm volatile("ds_read_b64_tr_b16 %0,%1 offset:%c2":"=&v"(hi[ks]):"v"(vb),"i"(d0*4096+ks*1024+512):"memory");}
    asm volatile("s_waitcnt lgkmcnt(0)":::"memory");SBAR();
    #define PK(k) (bf16x8){lo[k][0],lo[k][1],lo[k][2],lo[k][3],hi[k][0],hi[k][1],hi[k][2],hi[k][3]}
    o[d0]=__builtin_amdgcn_mfma_f32_32x32x16_bf16(pa0,PK(0),o[d0],0,0,0);
    o[d0]=__builtin_amdgcn_mfma_f32_32x32x16_bf16(pa1,PK(1),o[d0],0,0,0);
    o[d0]=__builtin_amdgcn_mfma_f32_32x32x16_bf16(pa2,PK(2),o[d0],0,0,0);
    o[d0]=__builtin_amdgcn_mfma_f32_32x32x16_bf16(pa3,PK(3),o[d0],0,0,0);
    #undef PK
  }
}

#ifndef ATTN_STORE16
#define ATTN_STORE16(p,v) (*(u32x4*)(p)=(v))
#endif
template<int THRL> __device__ __forceinline__ void attn_unit(long rowbase,int T,int h,int kvh,int qb,const bf16*__restrict__ QKV,bf16*Y,unsigned long long*ssqA,char*shm,float cref){
  int tid_=threadIdx.x; asm volatile("":"+v"(tid_)); const int tid=tid_,lane=tid&63,r32=lane&31,hi=lane>>5; const int wid=__builtin_amdgcn_readfirstlane(tid>>6);
  const int q0=qb*QB;
  const bf16*Qw=QKV+(rowbase+q0+wid*QBLK)*QP+h*D;
  const bf16*Kh=QKV+rowbase*QP+1024+kvh*D,*Vh=QKV+rowbase*QP+1536+kvh*D;
  const unsigned lds0=(unsigned)(uintptr_t)shm;
  float*wsf=(float*)(shm+LDS_WS)+wid*64;
  const bf16*ksrc=Kh+(long)lane*QP+wid*8;
  const bf16*vsrc=Vh+(long)(16*(wid&3)+(lane>>2))*QP+(wid>>2)*32+(lane&3)*8;
  const unsigned kdst=lds0+LDS_K+wid*1024, vdst=lds0+LDS_V+wid*1024;
  #define DMA_K(t,slot) glds16(ksrc+(long)(t)*KVBLK*QP,(unsigned)__builtin_amdgcn_readfirstlane(kdst+(slot)))
  #define DMA_V(t,slot) glds16(vsrc+(long)(t)*KVBLK*QP,(unsigned)__builtin_amdgcn_readfirstlane(vdst+(slot)))
  const int vb0=(int)(lds0+LDS_V)+((lane>>4)&1)*32+(lane&3)*8+(4*hi+((lane&15)>>2))*64;
  const char*Kbase=shm+LDS_K; bf16x8 kf[8];
  const lds_cptr shm3=(lds_cptr)shm; const lds_cptr kp0=shm3+LDS_K+hi*1024+r32*16; const lds_cptr vp0=shm3+LDS_V+((lane>>4)&1)*32+(lane&3)*8+(4*hi+((lane&15)>>2))*64;
  const int NT=T/KVBLK;
  DMA_K(0,0);DMA_V(0,0);DMA_K(1,SLOTB);
  bf16x8 qr[4];
  #pragma unroll
  for(int d0=0;d0<4;++d0)qr[d0]=*reinterpret_cast<const bf16x8*>(&Qw[(long)r32*QP+d0*16+hi*8]);
  float mhat=0.f,l_reg=0.f;f32x16 o[2];o[0]=f32x16{};o[1]=f32x16{};f32x16 negm;_Pragma("unroll") for(int r=0;r<16;++r)negm[r]=-cref;asm volatile("":"+v"(negm));
  const int qrel=wid*QBLK+r32;
  #define CMASK(P0,P1,t) do{}while(0)
  #define START(P0,P1) do{ _Pragma("unroll") for(int r=0;r<16;++r)P0[r]=__builtin_amdgcn_exp2f(P0[r]); }while(0)
  #define RESC() do{}while(0)
  f32x16 pA0,pA1,pB0,pB1;
  int sl_prev=0,sl_cur=0,sl_next=SLOTB;
  #define ROT() do{sl_prev=sl_cur;sl_cur=sl_next;sl_next=(sl_next==(NSLOT-1)*SLOTB)?0:sl_next+SLOTB;}while(0)
  DMA_K(2,2*SLOTB);
  WAIT_BAR(3);
  qkt(pA0,pA1,Kbase,qr,negm,r32,hi);asm volatile("s_nop 15\n\ts_nop 7":"+v"(pA0),"+v"(pA1));CMASK(pA0,pA1,0);
  START(pA0,pA1);
  _Pragma("unroll") for(int r=0;r<16;++r)pA1[r]=__builtin_amdgcn_exp2f(pA1[r]);
  WAIT_BAR(0);
  DMA_K(3,0);DMA_V(1,SLOTB);
  ROT();
  kload8(kf,kp0+sl_cur);
  WAIT_BAR(2);
  s16x4 vlo[8],vhi[8]; u32x4 pw0,pw1,pw2,pw3;
  #define PKW(P,B) cvtpk_s(P[B],P[B+1])
  #define PAF(k) __builtin_bit_cast(bf16x8,pw##k)
  #define VFR(i) (bf16x8){vlo[i][0],vlo[i][1],vlo[i][2],vlo[i][3],vhi[i][0],vhi[i][1],vhi[i][2],vhi[i][3]}
  #define PIN(x) asm volatile("":"+v"(x))
  #define MX3(a,b,c) __builtin_fmaxf(__builtin_fmaxf((a),(b)),(c))
  #define GAPA(MF,A0,A1,A2,A3,W0,W1,PW) do{ MF; sacc+=A0; sacc+=A1; sacc+=A2; sacc+=A3; PIN(sacc); W0; W1; PIN(PW); SBAR(); }while(0)
  #define EX(v) __builtin_amdgcn_exp2f(v)
  #define GAPB(MF,X,B) do{ MF; X[B]=EX(X[B]); X[B+1]=EX(X[B+1]); X[B+2]=EX(X[B+2]); X[B+3]=EX(X[B+3]); PIN(X); SBAR(); }while(0)
  #define VRD(i) do{ vlo[i]=vtr(vp_+(((i)>>2)*4096+((i)&3)*1024)); vhi[i]=vtr(vp_+(((i)>>2)*4096+((i)&3)*1024+512)); }while(0)
  #define KRD(G,j) do{ if(G){ kload2(kf,kp0+sl_next,j); SBAR(); } }while(0)
  #define STEP(C0,C1,P0,P1,t,GK,GV,GL) do{ SBAR(); \
    const lds_cptr vp_=vp0+sl_prev; \
    VRD(0); SBAR(); float sacc=(P0[0]+P0[1]); \
    GAPA(C0=__builtin_amdgcn_mfma_f32_32x32x16_bf16(kf[0],qr[0],negm,0,0,0), P0[2],P0[3],P0[4],P0[5],     pw0[0]=PKW(P0,0), pw0[1]=PKW(P0,2), pw0); \
    VRD(4); SBAR(); GAPA(C1=__builtin_amdgcn_mfma_f32_32x32x16_bf16(kf[1],qr[0],negm,0,0,0), P0[6],P0[7],P0[8],P0[9],     pw0[2]=PKW(P0,4), pw0[3]=PKW(P0,6), pw0); \
    VRD(1); SBAR(); GAPA(C0=__builtin_amdgcn_mfma_f32_32x32x16_bf16(kf[2],qr[1],C0,0,0,0),   P0[10],P0[11],P0[12],P0[13], pw1[0]=PKW(P0,8), pw1[1]=PKW(P0,10), pw1); \
    VRD(5); SBAR(); GAPA(C1=__builtin_amdgcn_mfma_f32_32x32x16_bf16(kf[3],qr[1],C1,0,0,0),   P0[14],P0[15],P1[0],P1[1],   pw1[2]=PKW(P0,12),pw1[3]=PKW(P0,14), pw1); \
    VRD(2); SBAR(); GAPA(C0=__builtin_amdgcn_mfma_f32_32x32x16_bf16(kf[4],qr[2],C0,0,0,0),   P1[2],P1[3],P1[4],P1[5],     pw2[0]=PKW(P1,0), pw2[1]=PKW(P1,2), pw2); \
    VRD(6); SBAR(); GAPA(C1=__builtin_amdgcn_mfma_f32_32x32x16_bf16(kf[5],qr[2],C1,0,0,0),   P1[6],P1[7],P1[8],P1[9],     pw2[2]=PKW(P1,4), pw2[3]=PKW(P1,6), pw2); \
    VRD(3); SBAR(); GAPA(C0=__builtin_amdgcn_mfma_f32_32x32x16_bf16(kf[6],qr[3],C0,0,0,0),   P1[10],P1[11],P1[12],P1[13], pw3[0]=PKW(P1,8), pw3[1]=PKW(P1,10), pw3); \
    VRD(7); SBAR(); GAPA(C1=__builtin_amdgcn_mfma_f32_32x32x16_bf16(kf[7],qr[3],C1,0,0,0),   P1[14],P1[15],0.f,0.f,       pw3[2]=PKW(P1,12),pw3[3]=PKW(P1,14), pw3); \
    l_reg+=sacc; \
    if(GK){DMA_K((t)+3,sl_cur);} if(GV){DMA_V((t)+1,sl_next);} \
    CMASK(C0,C1,t); \
    SBAR(); \
    GAPB(o[0]=__builtin_amdgcn_mfma_f32_32x32x16_bf16(PAF(0),VFR(0),o[0],0,0,0), C0,0); \
    GAPB(o[1]=__builtin_amdgcn_mfma_f32_32x32x16_bf16(PAF(0),VFR(4),o[1],0,0,0), C0,4); \
    KRD(GL,0); GAPB(o[0]=__builtin_amdgcn_mfma_f32_32x32x16_bf16(PAF(1),VFR(1),o[0],0,0,0), C0,8); \
    KRD(GL,1); GAPB(o[1]=__builtin_amdgcn_mfma_f32_32x32x16_bf16(PAF(1),VFR(5),o[1],0,0,0), C0,12); \
    KRD(GL,2); GAPB(o[0]=__builtin_amdgcn_mfma_f32_32x32x16_bf16(PAF(2),VFR(2),o[0],0,0,0), C1,0); \
    KRD(GL,3); GAPB(o[1]=__builtin_amdgcn_mfma_f32_32x32x16_bf16(PAF(2),VFR(6),o[1],0,0,0), C1,4); \
    GAPB(o[0]=__builtin_amdgcn_mfma_f32_32x32x16_bf16(PAF(3),VFR(3),o[0],0,0,0), C1,8); \
    GAPB(o[1]=__builtin_amdgcn_mfma_f32_32x32x16_bf16(PAF(3),VFR(7),o[1],0,0,0), C1,12); \
    }while(0)
  int t=1;
  #undef CMASK
  #define CMASK(P0,P1,t) do{}while(0)
  for(;t+5<NT;t+=2){
    STEP(pB0,pB1,pA0,pA1,t,true,true,true);     WAIT_BAR(2); RESC(); ROT();
    STEP(pA0,pA1,pB0,pB1,t+1,true,true,true);   WAIT_BAR(2); RESC(); ROT();
  }
  #undef CMASK
  #define CMASK(P0,P1,t) do{}while(0)
  #define ENDW(tt) do{ if((tt)+3<NT){WAIT_BAR(2);} else if((tt)+2<NT){WAIT_BAR(1);} else {WAIT_BAR(0);} }while(0)
  for(;t+1<NT;t+=2){
    STEP(pB0,pB1,pA0,pA1,t,(t+3<NT),(t+1<NT),(t+1<NT));       ENDW(t);   RESC(); ROT();
    STEP(pA0,pA1,pB0,pB1,t+1,(t+4<NT),(t+2<NT),(t+2<NT));     ENDW(t+1); RESC(); ROT();
  }
  STEP(pB0,pB1,pA0,pA1,NT-1,false,false,false); RESC();
  { float sacc=pB0[0]+pB0[1]; _Pragma("unroll") for(int r=2;r<16;++r)sacc+=pB0[r]; _Pragma("unroll") for(int r=0;r<16;++r)sacc+=pB1[r]; l_reg+=sacc;
    pw0=(u32x4){PKW(pB0,0),PKW(pB0,2),PKW(pB0,4),PKW(pB0,6)};pw1=(u32x4){PKW(pB0,8),PKW(pB0,10),PKW(pB0,12),PKW(pB0,14)};pw2=(u32x4){PKW(pB1,0),PKW(pB1,2),PKW(pB1,4),PKW(pB1,6)};pw3=(u32x4){PKW(pB1,8),PKW(pB1,10),PKW(pB1,12),PKW(pB1,14)};
    SBAR(); pv(o,vb0+sl_cur,PAF(0),PAF(1),PAF(2),PAF(3)); }
  #undef PKW
  #undef PAF
  #undef VFR
  #undef PIN
  #undef MX3
  #undef GAPA
  #undef GAPB
  #undef EX
  #undef VRD
  #undef KRD
  #undef STEP
  #undef ENDW
  {auto rr=__builtin_amdgcn_permlane32_swap(__float_as_uint(l_reg),__float_as_uint(l_reg),false,false);l_reg=__uint_as_float(rr[0])+__uint_as_float(rr[1]);}
  if(hi==0)wsf[32+r32]=l_reg;asm volatile("s_waitcnt lgkmcnt(0)":::"memory");
  float rli[16];
  #pragma unroll
  for(int r=0;r<16;++r)rli[r]=__builtin_amdgcn_rcpf(wsf[32+crow(r,hi)]);
  bf16*Ow=Y+(rowbase+q0+wid*QBLK)*OP+h*D; unsigned long long*sqw=ssqA+rowbase+q0+wid*QBLK;
  { bf16*stg=(bf16*)(shm+LDS_OST)+wid*2048;
    #pragma unroll
    for(int r=0;r<16;++r){const int orow=crow(r,hi);
      #pragma unroll
      for(int d0=0;d0<2;++d0)stg[orow*64+d0*32+r32]=__float2bfloat16(o[d0][r]*rli[r]);}
    asm volatile("s_waitcnt lgkmcnt(0)":::"memory");
    #pragma unroll
    for(int i=0;i<4;++i){const int row=i*8+(lane>>3),ch=lane&7; const u32x4 v=*(const u32x4*)(stg+row*64+ch*8); ATTN_STORE16(Ow+(long)row*OP+ch*8,v);
      float ss=0.f;
      #pragma unroll
      for(int w_=0;w_<4;++w_){const float a_=__uint_as_float(v[w_]<<16),b_=__uint_as_float(v[w_]&0xffff0000u);ss+=a_*a_+b_*b_;}
      ss+=__shfl_xor(ss,1);ss+=__shfl_xor(ss,2);ss+=__shfl_xor(ss,4); if(ch==0)atomicAdd(sqw+row,(unsigned long long)(ss*1073741824.0f));} }
  asm volatile("s_waitcnt lgkmcnt(0)\n\ts_barrier":::"memory");
  #undef DMA_K
  #undef DMA_V
  #undef CMASK
  #undef START
  #undef RESC
  #undef ROT
}
constexpr int ATTN_LDS_BYTES=LDS_BYTES;
#undef SBAR
#undef WAIT_BAR
}
namespace loc {
typedef unsigned short bf16_t;
typedef short bf16x8 __attribute__((ext_vector_type(8)));
typedef short s16x4 __attribute__((ext_vector_type(4)));
typedef float f32x4 __attribute__((ext_vector_type(4)));
typedef unsigned u32x4 __attribute__((ext_vector_type(4)));
typedef unsigned u32x2 __attribute__((ext_vector_type(2)));
#define LOC_LAS __attribute__((address_space(3)))
constexpr int VPITCH = 144;
constexpr int VBUF_BYTES = 32 * VPITCH;
__device__ __forceinline__ s16x4 trd(LOC_LAS char* p) { return __builtin_bit_cast(s16x4, __builtin_amdgcn_ds_read_tr16_b64_v4i16((LOC_LAS s16x4*)p)); }
typedef float f32x2_t __attribute__((ext_vector_type(2))); typedef __bf16 bf16x2_t __attribute__((ext_vector_type(2)));
__device__ __forceinline__ unsigned pk2(float lo, float hi) { f32x2_t v = {lo, hi}; bf16x2_t b = __builtin_convertvector(v, bf16x2_t); return __builtin_bit_cast(unsigned, b); }
__device__ __forceinline__ int clampi(int v, int lo, int hi) { return v < lo ? lo : (v > hi ? hi : v); }

template <int MIX>
__device__ __forceinline__ void local_unit(const bf16_t* __restrict__ QKV, const bf16_t* __restrict__ KVC, bf16_t* Y, const LOC_LAS float* rpbL, LOC_LAS char* vbuf,
                                           long seqrow, int T, int q0, int lane, float negC, LOC_LAS char* img, int rho_l, int imgpos0) {
    const int fr = lane & 15, g = lane >> 4;
    constexpr int QS = (MIX == 1) ? 1 : 16;
    const int qpos = q0 + QS * fr;
    float ss = 0.f;
#pragma unroll 1
    for (int pair = 0; pair < 3; ++pair) {
    const int qh0 = (MIX == 1 ? 4 : 10) + 2 * pair, kvh = (MIX == 1 ? 2 : 5) + pair;
    const bf16_t* qrow = QKV + (size_t)(seqrow + qpos) * 2048 + qh0 * 64 + 8 * g;
    bf16x8 qf[2][2];
#pragma unroll
    for (int h = 0; h < 2; ++h)
#pragma unroll
        for (int ks = 0; ks < 2; ++ks) qf[h][ks] = *(const bf16x8*)(qrow + h * 64 + 32 * ks);
    f32x4 o[2][4];
#pragma unroll
    for (int h = 0; h < 2; ++h)
#pragma unroll
        for (int c = 0; c < 4; ++c) o[h][c] = (f32x4){0.f, 0.f, 0.f, 0.f};
    float ls[2] = {0.f, 0.f};
    const int kvl = (MIX == 1 ? 0 : 3) + pair;
    const bf16_t* Kb = KVC + ((size_t)kvl * 49152 + seqrow) * 128 + 8 * g;
    const bf16_t* Vb = KVC + ((size_t)kvl * 49152 + seqrow) * 128 + 64 + (lane & 7) * 8;
    constexpr int NTILES = (MIX == 1) ? 8 : 23;
    constexpr int NG = (MIX == 1) ? 8 : 11;
    if (MIX == 2) {
        __syncthreads();
        const int t512 = rho_l * 64 + lane;
        const bf16_t* src = KVC + ((size_t)kvl * 49152 + seqrow) * 128;
        u32x4 w[12];
#pragma unroll
        for (int j = 0; j < 12; ++j) { const int cch = t512 + 512 * j, key = cch >> 4, part = cch & 15; const int kp = clampi(imgpos0 + key, 0, T - 1); w[j] = *(const u32x4*)(src + (size_t)kp * 128 + part * 8); }
#pragma unroll
        for (int j = 0; j < 12; ++j) { const int cch = t512 + 512 * j, key = cch >> 4, part = cch & 15;
            LOC_LAS char* d = (part < 8) ? img + key * 128 + ((part ^ (key & 7)) * 16) : img + 49152 + key * 128 + (((((part - 8) >> 1) ^ ((key >> 1) & 3)) * 2 + (part & 1)) * 16);
            *(LOC_LAS u32x4*)d = w[j]; }
        __syncthreads();
    }
    const int r = q0 >> 6, c = (q0 & 63) + fr, c0 = clampi(c - 8, 0, 48), r0 = clampi(r - 4, 0, (T >> 6) - 8), jq = (q0 & 63) >> 4;
    const int cb = jq == 0 ? 0 : (jq == 1 ? 8 : (jq == 2 ? 24 : 32));
    LOC_LAS char* vwr = vbuf + (lane >> 3) * VPITCH + (lane & 7) * 16;
    LOC_LAS char* vrd = vbuf + (4 * g + ((lane & 15) >> 2)) * VPITCH + (lane & 3) * 8;
    bf16x8 kn[2][2]; u32x4 vn[4];
#define LOC_TILE(it_, base_, s_) do { if (MIX == 1) { base_ = (r0 + (it_)) * 64 + cb; s_ = 1; } \
        else { if ((it_) < 5) { s_ = 16; base_ = q0 - 1024 + 512 * (it_); } else if ((it_) < 11) { s_ = 4; base_ = q0 - 256 + 128 * ((it_) - 5); } else { s_ = 1; base_ = q0 - 64 + 32 * ((it_) - 11); } } } while (0)
#define LOC_ISSUE(it_) do { int b_, s_; LOC_TILE(it_, b_, s_); \
        _Pragma("unroll") for (int ab = 0; ab < 2; ++ab) { const int kp = clampi(b_ + s_ * (16 * ab + fr), 0, T - 1); const bf16_t* p = Kb + (size_t)kp * 128; kn[ab][0] = *(const bf16x8*)p; kn[ab][1] = *(const bf16x8*)(p + 32); } \
        _Pragma("unroll") for (int i_ = 0; i_ < 4; ++i_) { const int kp = clampi(b_ + s_ * (8 * i_ + (lane >> 3)), 0, T - 1); vn[i_] = *(const u32x4*)(Vb + (size_t)kp * 128); } } while (0)
    LOC_ISSUE(0);
    for (int it = 0; it < NG; ++it) {
        int base, s; LOC_TILE(it, base, s);
        bf16x8 kf[2][2];
        constexpr bool fromimg = false;
        const int kbase = rho_l + 32 * (it - NG);
        if (!fromimg) {
#pragma unroll
            for (int ab = 0; ab < 2; ++ab) { kf[ab][0] = kn[ab][0]; kf[ab][1] = kn[ab][1]; }
            const u32x4 v0 = vn[0], v1 = vn[1], v2 = vn[2], v3 = vn[3];
            asm volatile("" : : "v"(kf[0][0]), "v"(kf[0][1]), "v"(kf[1][0]), "v"(kf[1][1]), "v"(v0), "v"(v1), "v"(v2), "v"(v3) : "memory");
            *(LOC_LAS u32x4*)(vwr) = v0; *(LOC_LAS u32x4*)(vwr + 8 * VPITCH) = v1; *(LOC_LAS u32x4*)(vwr + 16 * VPITCH) = v2; *(LOC_LAS u32x4*)(vwr + 24 * VPITCH) = v3;
            if (it + 1 < NG) LOC_ISSUE(it + 1);
        } else {
#pragma unroll
            for (int ab = 0; ab < 2; ++ab) { const int k = clampi(kbase + 16 * ab + fr, 0, 383); const LOC_LAS char* p = img + k * 128;
                kf[ab][0] = *(const LOC_LAS bf16x8*)(p + (((0 + g) ^ (k & 7)) * 16)); kf[ab][1] = *(const LOC_LAS bf16x8*)(p + (((4 + g) ^ (k & 7)) * 16)); }
        }
        asm volatile("" ::: "memory");
        f32x4 ini[2][2];
#pragma unroll
        for (int ab = 0; ab < 2; ++ab)
#pragma unroll
            for (int e = 0; e < 4; ++e) { const int j = 16 * ab + 4 * g + e;
                if (MIX == 1) { const int kc = cb + j; const bool valid = (unsigned)(kc - c0) < 16u; const int bidx = valid ? ((r0 + it - r + 7) * 31 + (kc - c + 15)) : 0;
                    float b0 = rpbL[(2 * pair) * 465 + bidx], b1 = rpbL[(2 * pair + 1) * 465 + bidx]; asm volatile("" : "+v"(b0), "+v"(b1));
                    ini[0][ab][e] = valid ? b0 : -1e30f; ini[1][ab][e] = valid ? b1 : -1e30f; }
                else { const int kp = base + s * j; const int dd = kp - qpos; const bool valid = ((unsigned)kp < (unsigned)T) & ((unsigned)(dd + 64 * s) <= (unsigned)(128 * s));
                    ini[0][ab][e] = valid ? negC : -1e30f; ini[1][ab][e] = ini[0][ab][e]; } }
        f32x4 sc[2][2];
#pragma unroll
        for (int h = 0; h < 2; ++h)
#pragma unroll
            for (int ab = 0; ab < 2; ++ab) { sc[h][ab] = __builtin_amdgcn_mfma_f32_16x16x32_bf16(kf[ab][0], qf[h][0], ini[h][ab], 0, 0, 0);
                sc[h][ab] = __builtin_amdgcn_mfma_f32_16x16x32_bf16(kf[ab][1], qf[h][1], sc[h][ab], 0, 0, 0); }
        bf16x8 vf[4];
#pragma unroll
        for (int cc = 0; cc < 4; ++cc) { LOC_LAS char* plo = vrd + cc * 32; LOC_LAS char* phi = vrd + 16 * VPITCH + cc * 32;
            if (fromimg) { const int qq = (lane & 15) >> 2, rlo = clampi(kbase + 4 * g + qq, 0, 383), rhi = clampi(kbase + 16 + 4 * g + qq, 0, 383);
                plo = img + 49152 + rlo * 128 + ((cc ^ ((rlo >> 1) & 3)) * 32) + (lane & 3) * 8; phi = img + 49152 + rhi * 128 + ((cc ^ ((rhi >> 1) & 3)) * 32) + (lane & 3) * 8; }
            const s16x4 lo = trd(plo), hi = trd(phi); vf[cc] = (bf16x8){lo[0], lo[1], lo[2], lo[3], hi[0], hi[1], hi[2], hi[3]}; }
        bf16x8 pf[2];
#pragma unroll
        for (int h = 0; h < 2; ++h) {
            float p[2][4]; float psum = 0.f;
#pragma unroll
            for (int ab = 0; ab < 2; ++ab)
#pragma unroll
                for (int e = 0; e < 4; ++e) { p[ab][e] = __builtin_amdgcn_exp2f(sc[h][ab][e]); psum += p[ab][e]; }
            ls[h] += psum;
            u32x4 w; w.x = pk2(p[0][0], p[0][1]); w.y = pk2(p[0][2], p[0][3]); w.z = pk2(p[1][0], p[1][1]); w.w = pk2(p[1][2], p[1][3]);
            pf[h] = __builtin_bit_cast(bf16x8, w);
        }
#pragma unroll
        for (int cc = 0; cc < 4; ++cc) {
            o[0][cc] = __builtin_amdgcn_mfma_f32_16x16x32_bf16(vf[cc], pf[0], o[0][cc], 0, 0, 0);
            o[1][cc] = __builtin_amdgcn_mfma_f32_16x16x32_bf16(vf[cc], pf[1], o[1][cc], 0, 0, 0);
        }
        asm volatile("" ::: "memory");
    }
    if (MIX == 2) {
#pragma unroll 4
    for (int it = NG; it < NTILES; ++it) {
        int base, s; LOC_TILE(it, base, s);
        bf16x8 kf[2][2];
        constexpr bool fromimg = true;
        const int kbase = rho_l + 32 * (it - NG);
        if (!fromimg) {
#pragma unroll
            for (int ab = 0; ab < 2; ++ab) { kf[ab][0] = kn[ab][0]; kf[ab][1] = kn[ab][1]; }
            const u32x4 v0 = vn[0], v1 = vn[1], v2 = vn[2], v3 = vn[3];
            asm volatile("" : : "v"(kf[0][0]), "v"(kf[0][1]), "v"(kf[1][0]), "v"(kf[1][1]), "v"(v0), "v"(v1), "v"(v2), "v"(v3) : "memory");
            *(LOC_LAS u32x4*)(vwr) = v0; *(LOC_LAS u32x4*)(vwr + 8 * VPITCH) = v1; *(LOC_LAS u32x4*)(vwr + 16 * VPITCH) = v2; *(LOC_LAS u32x4*)(vwr + 24 * VPITCH) = v3;
            if (it + 1 < NG) LOC_ISSUE(it + 1);
        } else {
#pragma unroll
            for (int ab = 0; ab < 2; ++ab) { const int k = clampi(kbase + 16 * ab + fr, 0, 383); const LOC_LAS char* p = img + k * 128;
                kf[ab][0] = *(const LOC_LAS bf16x8*)(p + (((0 + g) ^ (k & 7)) * 16)); kf[ab][1] = *(const LOC_LAS bf16x8*)(p + (((4 + g) ^ (k & 7)) * 16)); }
        }
        f32x4 ini[2][2];
#pragma unroll
        for (int ab = 0; ab < 2; ++ab)
#pragma unroll
            for (int e = 0; e < 4; ++e) { const int j = 16 * ab + 4 * g + e;
                if (MIX == 1) { const int kc = cb + j; const bool valid = (unsigned)(kc - c0) < 16u; const int bidx = valid ? ((r0 + it - r + 7) * 31 + (kc - c + 15)) : 0;
                    float b0 = rpbL[(2 * pair) * 465 + bidx], b1 = rpbL[(2 * pair + 1) * 465 + bidx]; asm volatile("" : "+v"(b0), "+v"(b1));
                    ini[0][ab][e] = valid ? b0 : -1e30f; ini[1][ab][e] = valid ? b1 : -1e30f; }
                else { const int kp = base + s * j; const int dd = kp - qpos; const bool valid = ((unsigned)kp < (unsigned)T) & ((unsigned)(dd + 64 * s) <= (unsigned)(128 * s));
                    ini[0][ab][e] = valid ? negC : -1e30f; ini[1][ab][e] = ini[0][ab][e]; } }
        f32x4 sc[2][2];
#pragma unroll
        for (int h = 0; h < 2; ++h)
#pragma unroll
            for (int ab = 0; ab < 2; ++ab) { sc[h][ab] = __builtin_amdgcn_mfma_f32_16x16x32_bf16(kf[ab][0], qf[h][0], ini[h][ab], 0, 0, 0);
                sc[h][ab] = __builtin_amdgcn_mfma_f32_16x16x32_bf16(kf[ab][1], qf[h][1], sc[h][ab], 0, 0, 0); }
        bf16x8 vf[4];
#pragma unroll
        for (int cc = 0; cc < 4; ++cc) { LOC_LAS char* plo = vrd + cc * 32; LOC_LAS char* phi = vrd + 16 * VPITCH + cc * 32;
            if (fromimg) { const int qq = (lane & 15) >> 2, rlo = clampi(kbase + 4 * g + qq, 0, 383), rhi = clampi(kbase + 16 + 4 * g + qq, 0, 383);
                plo = img + 49152 + rlo * 128 + ((cc ^ ((rlo >> 1) & 3)) * 32) + (lane & 3) * 8; phi = img + 49152 + rhi * 128 + ((cc ^ ((rhi >> 1) & 3)) * 32) + (lane & 3) * 8; }
            const s16x4 lo = trd(plo), hi = trd(phi); vf[cc] = (bf16x8){lo[0], lo[1], lo[2], lo[3], hi[0], hi[1], hi[2], hi[3]}; }
        bf16x8 pf[2];
#pragma unroll
        for (int h = 0; h < 2; ++h) {
            float p[2][4]; float psum = 0.f;
#pragma unroll
            for (int ab = 0; ab < 2; ++ab)
#pragma unroll
                for (int e = 0; e < 4; ++e) { p[ab][e] = __builtin_amdgcn_exp2f(sc[h][ab][e]); psum += p[ab][e]; }
            ls[h] += psum;
            u32x4 w; w.x = pk2(p[0][0], p[0][1]); w.y = pk2(p[0][2], p[0][3]); w.z = pk2(p[1][0], p[1][1]); w.w = pk2(p[1][2], p[1][3]);
            pf[h] = __builtin_bit_cast(bf16x8, w);
        }
#pragma unroll
        for (int cc = 0; cc < 4; ++cc) {
            o[0][cc] = __builtin_amdgcn_mfma_f32_16x16x32_bf16(vf[cc], pf[0], o[0][cc], 0, 0, 0);
            o[1][cc] = __builtin_amdgcn_mfma_f32_16x16x32_bf16(vf[cc], pf[1], o[1][cc], 0, 0, 0);
        }
    }
    }
    bf16_t* yrow = Y + (size_t)(seqrow + qpos) * 1024 + qh0 * 64 + 4 * g;
#pragma unroll
    for (int h = 0; h < 2; ++h) {
        float l = ls[h]; l += __shfl_xor(l, 16); l += __shfl_xor(l, 32);
        const float inv = 1.0f / l;
#pragma unroll
        for (int cc = 0; cc < 4; ++cc) { const f32x4 v = o[h][cc] * inv; u32x2 w; w.x = pk2(v[0], v[1]); w.y = pk2(v[2], v[3]);
            *(u32x2*)(yrow + h * 64 + 16 * cc) = w;
            const float a0 = __uint_as_float(w.x << 16), a1 = __uint_as_float(w.x & 0xffff0000u), a2 = __uint_as_float(w.y << 16), a3 = __uint_as_float(w.y & 0xffff0000u);
            ss += (a0 * a0 + a1 * a1) + (a2 * a2 + a3 * a3); }
    }
    }
    ss += __shfl_xor(ss, 16); ss += __shfl_xor(ss, 32);
    const float f = rsqrtf(ss * (1.0f / 384.0f) + 1e-6f);
    asm volatile("s_waitcnt vmcnt(0)" ::: "memory");
    { bf16_t* yb = Y + (size_t)(seqrow + qpos) * 1024 + (MIX == 1 ? 4 : 10) * 64 + 4 * g;
      u32x2 w[24];
#pragma unroll
      for (int i = 0; i < 24; ++i) w[i] = *(const u32x2*)(yb + 16 * i);
#pragma unroll
      for (int i = 0; i < 24; ++i) { u32x2 v = w[i]; v.x = pk2(__uint_as_float(v.x << 16) * f, __uint_as_float(v.x & 0xffff0000u) * f); v.y = pk2(__uint_as_float(v.y << 16) * f, __uint_as_float(v.y & 0xffff0000u) * f);
          *(u32x2*)(yb + 16 * i) = v; } }
}
#undef LOC_TILE
#undef LOC_ISSUE

__device__ __forceinline__ void local_unit_nb(const bf16_t* __restrict__ QKV, const bf16_t* __restrict__ KVC, bf16_t* Y, const LOC_LAS float* rpbL, LOC_LAS char* img,
                                              long seqrow, int T, int gr0, int wave, int lane) {
    const int fr = lane & 15, g = lane >> 4;
    const int rows = T >> 6;
    const int r = gr0 + (wave >> 2), jq = wave & 3;
    const int q0 = r * 64 + 16 * jq, qpos = q0 + fr;
    const int c = 16 * jq + fr, c0 = clampi(c - 8, 0, 48), r0 = clampi(r - 4, 0, rows - 8);
    const int cb = jq == 0 ? 0 : (jq == 1 ? 8 : (jq == 2 ? 24 : 32));
    const int R0 = clampi(gr0 - 4, 0, rows - 8);
    const int t512 = wave * 64 + lane;
    const bf16_t* src0 = KVC + (size_t)seqrow * 128;
    float ss = 0.f;
    u32x4 w[6];
#define NB_LOAD(q_) do { const bf16_t* s_ = src0 + (size_t)((q_) / 3) * 49152 * 128; const int p0_ = (R0 + 3 * ((q_) % 3)) * 64; \
        _Pragma("unroll") for (int j = 0; j < 6; ++j) { const int cch = t512 + 512 * j, key = cch >> 4, part = cch & 15; const int kp = clampi(p0_ + key, 0, T - 1); w[j] = *(const u32x4*)(s_ + (size_t)kp * 128 + part * 8); } } while (0)
#define NB_STORE(q_) do { LOC_LAS char* b_ = img + ((q_) & 1) * 49152; \
        _Pragma("unroll") for (int j = 0; j < 6; ++j) { const int cch = t512 + 512 * j, key = cch >> 4, part = cch & 15; \
            LOC_LAS char* d = (part < 8) ? b_ + key * 128 + ((part ^ (key & 7)) * 16) : b_ + 24576 + key * 128 + (((((part - 8) >> 1) ^ ((key >> 1) & 3)) * 2 + (part & 1)) * 16); \
            *(LOC_LAS u32x4*)d = w[j]; } } while (0)
    __syncthreads();
    NB_LOAD(0); NB_STORE(0);
    __syncthreads();
    bf16x8 qf[2][2]; f32x4 o[2][4]; float ls[2];
#pragma unroll 1
    for (int q = 0; q < 9; ++q) {
        const int pair = q / 3, pass = q - 3 * pair;
        if (q + 1 < 9) NB_LOAD(q + 1);
        if (pass == 0) {
            const bf16_t* qrow = QKV + (size_t)(seqrow + qpos) * 2048 + (4 + 2 * pair) * 64 + 8 * g;
#pragma unroll
            for (int h = 0; h < 2; ++h)
#pragma unroll
                for (int ks = 0; ks < 2; ++ks) qf[h][ks] = *(const bf16x8*)(qrow + h * 64 + 32 * ks);
#pragma unroll
            for (int h = 0; h < 2; ++h)
#pragma unroll
                for (int cc = 0; cc < 4; ++cc) o[h][cc] = (f32x4){0.f, 0.f, 0.f, 0.f};
            ls[0] = 0.f; ls[1] = 0.f;
        }
        LOC_LAS char* ib = img + (q & 1) * 49152;
        const int Rp = R0 + 3 * pass;
        const int klo = r0 > Rp ? r0 : Rp, khi = (r0 + 8 < Rp + 3) ? r0 + 8 : Rp + 3;
#pragma unroll 3
        for (int kr = klo; kr < khi; ++kr) {
            const int kbase = (kr - Rp) * 64 + cb;
            bf16x8 kf[2][2];
#pragma unroll
            for (int ab = 0; ab < 2; ++ab) { const int k = kbase + 16 * ab + fr; const LOC_LAS char* p = ib + k * 128;
                kf[ab][0] = *(const LOC_LAS bf16x8*)(p + (((0 + g) ^ (k & 7)) * 16)); kf[ab][1] = *(const LOC_LAS bf16x8*)(p + (((4 + g) ^ (k & 7)) * 16)); }
            f32x4 ini[2][2];
#pragma unroll
            for (int ab = 0; ab < 2; ++ab)
#pragma unroll
                for (int e = 0; e < 4; ++e) { const int kc = cb + 16 * ab + 4 * g + e; const bool valid = (unsigned)(kc - c0) < 16u; const int bidx = valid ? ((kr - r + 7) * 31 + (kc - c + 15)) : 0;
                    ini[0][ab][e] = rpbL[(2 * pair) * 465 + bidx]; ini[1][ab][e] = rpbL[(2 * pair + 1) * 465 + bidx]; }
            asm volatile("" : "+v"(ini[0][0]), "+v"(ini[0][1]), "+v"(ini[1][0]), "+v"(ini[1][1]));
#pragma unroll
            for (int ab = 0; ab < 2; ++ab)
#pragma unroll
                for (int e = 0; e < 4; ++e) { const int kc = cb + 16 * ab + 4 * g + e; const bool valid = (unsigned)(kc - c0) < 16u;
                    ini[0][ab][e] = valid ? ini[0][ab][e] : -1e30f; ini[1][ab][e] = valid ? ini[1][ab][e] : -1e30f; }
            f32x4 sc[2][2];
#pragma unroll
            for (int h = 0; h < 2; ++h)
#pragma unroll
                for (int ab = 0; ab < 2; ++ab) { sc[h][ab] = __builtin_amdgcn_mfma_f32_16x16x32_bf16(kf[ab][0], qf[h][0], ini[h][ab], 0, 0, 0);
                    sc[h][ab] = __builtin_amdgcn_mfma_f32_16x16x32_bf16(kf[ab][1], qf[h][1], sc[h][ab], 0, 0, 0); }
            bf16x8 vf[4];
#pragma unroll
            for (int cc = 0; cc < 4; ++cc) { const int qq = (lane & 15) >> 2; const int rlo = kbase + 4 * g + qq, rhi = rlo + 16;
                LOC_LAS char* plo = ib + 24576 + rlo * 128 + ((cc ^ ((rlo >> 1) & 3)) * 32) + (lane & 3) * 8; LOC_LAS char* phi = ib + 24576 + rhi * 128 + ((cc ^ ((rhi >> 1) & 3)) * 32) + (lane & 3) * 8;
                const s16x4 lo = trd(plo), hi = trd(phi); vf[cc] = (bf16x8){lo[0], lo[1], lo[2], lo[3], hi[0], hi[1], hi[2], hi[3]}; }
            bf16x8 pf[2];
#pragma unroll
            for (int h = 0; h < 2; ++h) {
                float p[2][4]; float psum = 0.f;
#pragma unroll
                for (int ab = 0; ab < 2; ++ab)
#pragma unroll
                    for (int e = 0; e < 4; ++e) { p[ab][e] = __builtin_amdgcn_exp2f(sc[h][ab][e]); psum += p[ab][e]; }
                ls[h] += psum;
                u32x4 w_; w_.x = pk2(p[0][0], p[0][1]); w_.y = pk2(p[0][2], p[0][3]); w_.z = pk2(p[1][0], p[1][1]); w_.w = pk2(p[1][2], p[1][3]);
                pf[h] = __builtin_bit_cast(bf16x8, w_);
            }
#pragma unroll
            for (int cc = 0; cc < 4; ++cc) {
                o[0][cc] = __builtin_amdgcn_mfma_f32_16x16x32_bf16(vf[cc], pf[0], o[0][cc], 0, 0, 0);
                o[1][cc] = __builtin_amdgcn_mfma_f32_16x16x32_bf16(vf[cc], pf[1], o[1][cc], 0, 0, 0);
            }
        }
        if (pass == 2) {
            bf16_t* yrow = Y + (size_t)(seqrow + qpos) * 1024 + (4 + 2 * pair) * 64 + 4 * g;
#pragma unroll
            for (int h = 0; h < 2; ++h) {
                float l_ = ls[h]; l_ += __shfl_xor(l_, 16); l_ += __shfl_xor(l_, 32);
                const float inv = 1.0f / l_;
#pragma unroll
                for (int cc = 0; cc < 4; ++cc) { const f32x4 v = o[h][cc] * inv; u32x2 w2; w2.x = pk2(v[0], v[1]); w2.y = pk2(v[2], v[3]);
                    *(u32x2*)(yrow + h * 64 + 16 * cc) = w2;
                    const float a0 = __uint_as_float(w2.x << 16), a1 = __uint_as_float(w2.x & 0xffff0000u), a2 = __uint_as_float(w2.y << 16), a3 = __uint_as_float(w2.y & 0xffff0000u);
                    ss += (a0 * a0 + a1 * a1) + (a2 * a2 + a3 * a3); }
            }
        }
        if (q + 1 < 9) NB_STORE(q + 1);
        __syncthreads();
    }
#undef NB_LOAD
#undef NB_STORE
    ss += __shfl_xor(ss, 16); ss += __shfl_xor(ss, 32);
    const float f = rsqrtf(ss * (1.0f / 384.0f) + 1e-6f);
    asm volatile("s_waitcnt vmcnt(0)" ::: "memory");
    { bf16_t* yb = Y + (size_t)(seqrow + qpos) * 1024 + 4 * 64 + 4 * g;
      u32x2 w3[24];
#pragma unroll
      for (int i = 0; i < 24; ++i) w3[i] = *(const u32x2*)(yb + 16 * i);
#pragma unroll
      for (int i = 0; i < 24; ++i) { u32x2 v = w3[i]; v.x = pk2(__uint_as_float(v.x << 16) * f, __uint_as_float(v.x & 0xffff0000u) * f); v.y = pk2(__uint_as_float(v.y << 16) * f, __uint_as_float(v.y & 0xffff0000u) * f);
          *(u32x2*)(yb + 16 * i) = v; } }
}
}
#include <hip/hip_cooperative_groups.h>
namespace cg = cooperative_groups;
#define LAS __attribute__((address_space(3)))
typedef unsigned short bf16;
typedef unsigned v4u __attribute__((ext_vector_type(4)));
typedef float f32x4 __attribute__((ext_vector_type(4)));

constexpr int DM = 1024, DEPTH = 4, QKVW = 2048, FF = 2816, M_TOK = 49152, M_PROMPT = 16384;
constexpr size_t MiB = 1u << 20;
constexpr size_t WS_CTL = 0;
constexpr size_t WS_TAB = 1 * MiB;
constexpr size_t WS_SSQ = 482 * MiB;
constexpr size_t WS_W = 8 * MiB;
constexpr size_t WS_XB = 98 * MiB;
constexpr size_t WS_QKV = 194 * MiB;
constexpr size_t WS_Y = 386 * MiB;
constexpr size_t WS_H = 194 * MiB;
constexpr size_t WS_END = 490 * MiB;
constexpr size_t W_IN = 0, W_OUT = 2097152, W_GU = 3145728, W_DOWN = 8912896, W_LAYER = 11796480;
#ifndef PG_ALIGN
#define PG_ALIGN true
#endif
#ifndef PG_SP2
#define PG_SP2 true
#endif
constexpr int LDS_BYTES = 147456;
constexpr int MISC_OFF = 147392;
constexpr int BND_OFF = 264192 + 4 * 384;
constexpr int RPB_OFF = 135168;
constexpr int N_LOCAL_ITEMS = 18432;

struct Args { const float* in[12]; float* out; unsigned char* ws; };

__device__ __forceinline__ unsigned f2bf(float f) { unsigned u = __builtin_bit_cast(unsigned, f); return (u + 0x7fffu + ((u >> 16) & 1u)) >> 16; }
__device__ __forceinline__ unsigned pk2h(float lo, float hi) { return f2bf(lo) | (f2bf(hi) << 16); }
__device__ __forceinline__ float wave_sum(float v) {
#pragma unroll
    for (int o = 1; o < 64; o <<= 1) v += __shfl_xor(v, o);
    return v;
}
__device__ __forceinline__ int jrow(int kind, int n) {
    if (kind == 0) {
        const int hd = n >> 6, d = n & 63, pn = hd >> 2, wc = hd & 3;
        const bool typeA = (hd < 4) || (hd == 16) || (hd == 17);
        int fq, bj; if (typeA) { fq = 2 * (d >> 5) + ((d >> 3) & 1); bj = (d >> 4) & 1; } else { fq = (d >> 3) & 3; bj = d >> 5; }
        return 256 * pn + 128 * bj + 32 * wc + 8 * fq + (d & 7);
    } else if (kind == 2) {
        const int bj = n >= FF ? 1 : 0, jh = n - bj * FF;
        return 256 * (jh >> 7) + 128 * bj + (jh & 127);
    }
    return n;
}
__device__ __forceinline__ void transpose_item(const float* W, int K, int N, bf16* WT, int kind, const float* gk, LAS float* scr, int item, int lane) {
    const int nblk = N / 32, kb = item / nblk, nb = item % nblk, k0 = 64 * kb, n0 = 32 * nb;
#pragma unroll 8
    for (int i = 0; i < 32; ++i) { const int kk = 2 * i + (lane >> 5); const float gsc = gk ? gk[k0 + kk] : 1.f; scr[kk * 33 + (lane & 31)] = W[(size_t)(k0 + kk) * N + n0 + (lane & 31)] * gsc; }
    asm volatile("s_waitcnt lgkmcnt(0)" ::: "memory");
    const int c = lane & 7;
#pragma unroll
    for (int j = 0; j < 4; ++j) { const int n = (lane >> 3) + 8 * j; const LAS float* s = scr + (8 * c) * 33 + n;
        v4u o; o.x = pk2h(s[0 * 33], s[1 * 33]); o.y = pk2h(s[2 * 33], s[3 * 33]); o.z = pk2h(s[4 * 33], s[5 * 33]); o.w = pk2h(s[6 * 33], s[7 * 33]);
        *(v4u*)(WT + (size_t)jrow(kind, n0 + n) * K + k0 + 8 * c) = o; }
    asm volatile("s_waitcnt lgkmcnt(0)" ::: "memory");
}

#define XB_TMO      128
#define XB_XCNT(j)  (256  + 64 * (j))
#define XB_XSUB(j)  (1280 + 64 * (j))
#define XB_XGEN(j)  (2304 + 64 * (j))
#define XB_TOP      3328
#define XB_TOPGEN   3392
#define XCD_BAR_WORDS 3456
#define XB_SPIN_CAP (1u << 18)

__device__ __forceinline__ unsigned xb_ld(unsigned* p)              { return __hip_atomic_load(p, __ATOMIC_RELAXED, __HIP_MEMORY_SCOPE_AGENT); }
__device__ __forceinline__ unsigned xb_add(unsigned* p, unsigned v) { return __hip_atomic_fetch_add(p, v, __ATOMIC_RELAXED, __HIP_MEMORY_SCOPE_AGENT); }
__device__ __forceinline__ unsigned xb_xcc_id() { return (unsigned)__builtin_amdgcn_s_getreg((3 << 11) | 20) & 0xFu; }
#define XB_SPIN(cond, bar) do { unsigned _sp = 0; while (cond) { __builtin_amdgcn_s_sleep(1); \
    if ((++_sp & 255u) == 0u) { if (xb_ld(&(bar)[XB_TMO])) break; if (_sp > XB_SPIN_CAP) { atomicAdd(&(bar)[XB_TMO], 1u); break; } } } } while (0)

struct XcdBarrier {
    unsigned* bar; unsigned x;
    volatile LAS unsigned* st;
};

__device__ __forceinline__ XcdBarrier xcd_barrier_post(unsigned* bar, volatile LAS unsigned* st) {
    XcdBarrier b; b.bar = bar; b.x = xb_xcc_id(); b.st = st;
    if (threadIdx.x == 0) (void)xb_add(&bar[XB_XCNT(b.x)], 1u);
    return b;
}
__device__ __forceinline__ void xcd_barrier_complete(unsigned* bar, unsigned x, unsigned& nloc, unsigned& nx) {
    const unsigned G = gridDim.x * gridDim.y * gridDim.z;
    unsigned sum, cnt, mine, sp = 0u;
    for (;;) {
        sum = 0u; cnt = 0u; mine = 0u;
#pragma unroll
        for (unsigned j = 0; j < 16; ++j) { const unsigned c = xb_ld(&bar[XB_XCNT(j)]); sum += c; cnt += (c > 0u) ? 1u : 0u; mine = (j == x) ? c : mine; }
        if (sum == G) break;
        __builtin_amdgcn_s_sleep(1);
        if ((++sp & 255u) == 0u) { if (xb_ld(&bar[XB_TMO])) break; if (sp > XB_SPIN_CAP) { atomicAdd(&bar[XB_TMO], 1u); break; } }
    }
    nloc = mine > 0u ? mine : 1u; nx = cnt > 0u ? cnt : 1u;
}

__device__ __forceinline__ void xcd_barrier(const XcdBarrier& b) {
    asm volatile("s_waitcnt vmcnt(0)" ::: "memory");
    __syncthreads();
    if (threadIdx.x == 0) {
        unsigned* bar = b.bar;
        __builtin_amdgcn_s_waitcnt(0);
        unsigned nloc = b.st[0], nx = b.st[1];
        if (nloc == 0u) { xcd_barrier_complete(bar, b.x, nloc, nx); b.st[0] = nloc; b.st[1] = nx; }
        const unsigned old = xb_add(&bar[XB_XSUB(b.x)], 1u);
        const unsigned gen = old / nloc;
        if (old + 1u == (gen + 1u) * nloc) {
            __builtin_amdgcn_fence(__ATOMIC_RELEASE, "agent");
            asm volatile("s_waitcnt vmcnt(0)" ::: "memory");
            const unsigned og = xb_add(&bar[XB_TOP], 1u);
            const unsigned tg = og / nx;
            if (og + 1u == (tg + 1u) * nx) xb_add(&bar[XB_TOPGEN], 1u);
            else XB_SPIN(xb_ld(&bar[XB_TOPGEN]) == tg, bar);
            __builtin_amdgcn_fence(__ATOMIC_ACQUIRE, "agent");
            xb_add(&bar[XB_XGEN(b.x)], 1u);
            asm volatile("s_waitcnt vmcnt(0)" ::: "memory");
        } else {
            XB_SPIN(xb_ld(&bar[XB_XGEN(b.x)]) == gen, bar);
            __builtin_amdgcn_fence(__ATOMIC_ACQUIRE, "agent");
            asm volatile("s_waitcnt vmcnt(0)" ::: "memory");
        }
    }
    __syncthreads();
}

__global__ void __launch_bounds__(512) fwd_megakernel(Args args) {
    extern __shared__ __attribute__((aligned(16))) unsigned char lds[];
    cg::grid_group grid = cg::this_grid();
    const int tid = threadIdx.x, lane = tid & 63, wave = __builtin_amdgcn_readfirstlane(tid >> 6);
    const int G = gridDim.x, bx = blockIdx.x;
    const int vcu = (G % 8 == 0) ? (bx % 8) * (G / 8) + bx / 8 : bx;
    unsigned char* ws = args.ws;
    const float* x_prompt = args.in[0]; const float* x_sample = args.in[1]; const float* norm_mix = args.in[2]; const float* w_in = args.in[3];
    const float* q_gain = args.in[4]; const float* k_gain = args.in[5]; const float* rpb = args.in[6]; const float* out_gain = args.in[7];
    const float* w_out = args.in[8]; const float* norm_ffn = args.in[9]; const float* w_gate_up = args.in[10]; const float* w_down = args.in[11];
    unsigned* ctl = (unsigned*)(ws + WS_CTL);
    float* cos1 = (float*)(ws + WS_TAB); float* sin1 = cos1 + 4096 * 32; float* cosax = sin1 + 4096 * 32; float* sinax = cosax + 64 * 16;
    typedef unsigned long long u64;
    u64* ssq = (u64*)(ws + WS_SSQ);
    bf16* Wb = (bf16*)(ws + WS_W); bf16* XB = (bf16*)(ws + WS_XB); bf16* QKV = (bf16*)(ws + WS_QKV); bf16* Y = (bf16*)(ws + WS_Y); bf16* H = (bf16*)(ws + WS_H);
    float* out = args.out;
    LAS unsigned char* ldsl = (LAS unsigned char*)lds;
    if (tid < 16) ((LAS unsigned*)(ldsl + MISC_OFF))[tid] = 0u;
    __syncthreads();

#ifndef NO_P0
    {
        const int gw = vcu * 8 + wave, NGW = G * 8, gt = bx * 512 + tid, NGT = G * 512;
        for (int i = gt; i < 8192; i += NGT) ctl[i] = 0u;
        { v4u* z = (v4u*)(ssq + M_TOK); const int nz = 19 * M_TOK / 2; for (int i = gt; i < nz; i += NGT) z[i] = (v4u){0u, 0u, 0u, 0u}; }
        for (int i = gt; i < 4096 * 32 + 64 * 16; i += NGT) {
            int pos, f; float invf;
            if (i < 4096 * 32) { pos = i >> 5; f = i & 31; invf = exp2f(-(float)f * (13.287712379549449f / 32.0f)); }
            else { const int k = i - 4096 * 32; pos = k >> 4; f = k & 15; invf = exp2f(-(float)f * (13.287712379549449f / 16.0f)); }
            const float ang = (float)pos * invf;
            const double rev = (double)ang * 0.15915494309189535; const float fr_ = (float)(rev - __builtin_rint(rev));
            const float cv = __builtin_amdgcn_cosf(fr_), sv = __builtin_amdgcn_sinf(fr_);
            if (i < 4096 * 32) { cos1[i] = cv; sin1[i] = sv; } else { cosax[i - 4096 * 32] = cv; sinax[i - 4096 * 32] = sv; }
        }
        for (int i = gt; i < DEPTH * 384; i += NGT) { const int l_ = i / 384, r_ = i % 384; cos1[264192 + i] = r_ < 192 ? q_gain[l_ * 192 + r_] : k_gain[l_ * 192 + r_ - 192]; }
        if (gw < 12) { const int l_ = gw / 3, mx_ = gw % 3; float a = fabsf(q_gain[l_ * 192 + mx_ * 64 + lane]), b = fabsf(k_gain[l_ * 192 + mx_ * 64 + lane]), c = 0.f;
            if (mx_ == 1) for (int i = lane; i < 6 * 465; i += 64) c = fmaxf(c, fabsf(rpb[(size_t)l_ * 6 * 465 + i]));
#pragma unroll
            for (int o = 1; o < 64; o <<= 1) { a = fmaxf(a, __shfl_xor(a, o)); b = fmaxf(b, __shfl_xor(b, o)); c = fmaxf(c, __shfl_xor(c, o)); }
            if (lane == 0) cos1[BND_OFF + l_ * 4 + mx_] = (8.0f * a * b + c) * 1.4426950408889634f * 1.02f; }
        LAS float* scr = (LAS float*)(ldsl + wave * 16384);
        constexpr int I_IN = 16 * 64, I_OUT = 16 * 32, I_GU = 16 * 176, I_DN = 44 * 32, I_LAYER = I_IN + I_OUT + I_GU + I_DN;
        for (int it = gw; it < DEPTH * I_LAYER; it += NGW) {
            const int l = it / I_LAYER; int r = it % I_LAYER; bf16* Wl = Wb + (size_t)l * W_LAYER;
            if (r < I_IN) { transpose_item(w_in + (size_t)l * DM * QKVW, DM, QKVW, Wl + W_IN, 0, norm_mix + l * DM, scr, r, lane); continue; } r -= I_IN;
            if (r < I_OUT) { transpose_item(w_out + (size_t)l * DM * DM, DM, DM, Wl + W_OUT, 1, out_gain + l * DM, scr, r, lane); continue; } r -= I_OUT;
            if (r < I_GU) { transpose_item(w_gate_up + (size_t)l * DM * 2 * FF, DM, 2 * FF, Wl + W_GU, 2, norm_ffn + l * DM, scr, r, lane); continue; } r -= I_GU;
            transpose_item(w_down + (size_t)l * FF * DM, FF, DM, Wl + W_DOWN, 1, nullptr, scr, r, lane);
        }
        for (int m0 = gw; m0 < M_TOK; m0 += 4 * NGW) {
            f32x4 v[4][4];
#pragma unroll
            for (int r_ = 0; r_ < 4; ++r_) { const int m = m0 + r_ * NGW; if (m < M_TOK) {
                const float* xrow = m < M_PROMPT ? x_prompt + (size_t)m * DM : x_sample + (size_t)(m - M_PROMPT) * DM; const f32x4* xr = (const f32x4*)xrow + lane;
#pragma unroll
                for (int j = 0; j < 4; ++j) v[r_][j] = xr[64 * j]; } }
#pragma unroll
            for (int r_ = 0; r_ < 4; ++r_) { const int m = m0 + r_ * NGW; if (m < M_TOK) {
                float s = 0.f;
#pragma unroll
                for (int j = 0; j < 4; ++j) s += (v[r_][j].x * v[r_][j].x + v[r_][j].y * v[r_][j].y) + (v[r_][j].z * v[r_][j].z + v[r_][j].w * v[r_][j].w);
                s = wave_sum(s);
                unsigned long long* o8 = (unsigned long long*)(XB + (size_t)m * DM) + lane;
#pragma unroll
                for (int j = 0; j < 4; ++j) o8[64 * j] = (unsigned long long)pk2h(v[r_][j].x, v[r_][j].y) | ((unsigned long long)pk2h(v[r_][j].z, v[r_][j].w) << 32);
                if (lane == 0) ssq[m] = (u64)(s * 1073741824.0f); } }
        }
    }
#endif
    grid.sync();
    XcdBarrier xbar = xcd_barrier_post(ctl + 4096, (volatile LAS unsigned*)(ldsl + MISC_OFF));
#define GRID_BAR() xcd_barrier(xbar)

    for (int l = 0; l < DEPTH; ++l) {
        const bf16* Wl = Wb + (size_t)l * W_LAYER;
        int tidl = threadIdx.x; asm volatile("" : "+v"(tidl)); const int lanel = tidl & 63;
        u64* ssq_mix = ssq + (size_t)l * M_TOK; u64* ssq_ffn = ssq + (size_t)(4 + l) * M_TOK;
        u64* ssqA = ssq + (size_t)(8 + l) * M_TOK; u64* ssqB = ssq + (size_t)(12 + l) * M_TOK; u64* ssqC = ssq + (size_t)(16 + l) * M_TOK;
#ifndef NO_P1
        {
            pg8::Gemm g{XB, Wl + W_IN, M_TOK, QKVW, DM}; pg8::StaticOrder S; S.init(M_TOK, QKVW, G, bx);
            pg8::EpiQKV E{QKV, (bf16*)out, ssq_mix, (const float*)(ws + WS_TAB), l, ldsl + 131072};
            pg8::gemm_phase<pg8::EpiQKV, pg8::StaticOrder, PG_ALIGN, PG_SP2>(ldsl, g, S, E);
#ifdef PROBE_P1X2
            __syncthreads();
            pg8::gemm_phase<pg8::EpiQKV, pg8::StaticOrder, PG_ALIGN, PG_SP2>(ldsl, g, S, E);
#endif
        }
#endif
        GRID_BAR();
        {
            LAS float* rpbL = (LAS float*)(ldsl + RPB_OFF);
            const float cA = cos1[BND_OFF + l * 4 + 0], cB = cos1[BND_OFF + l * 4 + 1], cC = cos1[BND_OFF + l * 4 + 2];
            for (int i = tidl; i < 6 * 465; i += 512) rpbL[i] = rpb[(size_t)l * 6 * 465 + i] * 1.4426950408889634f - cB;
            if (tidl == 0) ((volatile LAS unsigned*)(ldsl + MISC_OFF))[4] = 0u;
            __syncthreads();
#ifndef NO_P2A
            const bool clsX = (vcu & 1) == 0; const int crank = vcu >> 1;
            const int nA = (G == 256) ? (clsX ? 2 : 4) : (768 + G - 1 - vcu) / G;
            for (int ia = 0; ia < nA; ++ia) {
                const int u = (G == 256) ? (ia == 0 ? vcu : (clsX ? 256 + crank : 256 + 128 + 3 * crank + (ia - 1))) : vcu + ia * G;
                long rowbase; int T, h, kvh, qb;
                if (u < 256) { const int grp = u >> 5, j = u & 31; kvh = grp & 1; rowbase = (long)(grp >> 1) * 4096; T = 4096; h = 2 * kvh + (j >> 4); qb = j & 15; }
                else { const int su = u - 256, grp = su >> 4, j = su & 15; kvh = grp & 1; rowbase = M_PROMPT + (long)(grp >> 1) * 2048; T = 2048; h = 2 * kvh + (j >> 3); qb = j & 7; }
                attn_body::attn_unit<8>(rowbase, T, h, kvh, qb, (const attn_body::bf16*)QKV, (attn_body::bf16*)Y, ssqA, (char*)lds, cA);
#ifdef PROBE_AX2
                attn_body::attn_unit<8>(rowbase, T, h, kvh, qb, (const attn_body::bf16*)QKV, (attn_body::bf16*)Y, (u64*)XB, (char*)lds, cA);
#endif
            }
#endif
#ifndef NO_P2L
            LAS char* vbuf = (LAS char*)(ldsl + 98304 + wave * loc::VBUF_BYTES);
            {
                const bool bal = (G == 256), lowh = clsX;
                const int nC = bal ? (lowh ? 2 : 1) : (384 + G - 1 - vcu) / G, nB = bal ? (lowh ? 1 : 2) : (384 + G - 1 - vcu) / G;
#ifdef PROBE_LOCAL2
                for (int rep = 0; rep < 2; ++rep)
#endif
                for (int k = 0; k < nC + nB; ++k) {
                    const bool isC = k < nC;
                    int uid;
                    if (isC) uid = bal ? (lowh ? 2 * crank + k : 256 + crank) : vcu + k * G;
                    else uid = bal ? (lowh ? crank : 128 + 2 * crank + (k - nC)) : vcu + (k - nC) * G;
                    __syncthreads();
                    int lane_o = lanel; asm volatile("" : "+v"(lane_o));
                    const int g0 = isC ? (uid >> 1) * 256 : uid * 128 + wave * 16;
                    long seqrow; int T; if (g0 < M_PROMPT) { T = 4096; seqrow = g0 & ~4095; } else { T = 2048; seqrow = g0 & ~2047; }
                    if (isC) loc::local_unit<2>(QKV, (const bf16*)out, Y, rpbL, vbuf, seqrow, T, (g0 - (int)seqrow) + 8 * (uid & 1) + wave, lane_o, -cC, (LAS char*)ldsl, wave, (g0 - (int)seqrow) + 8 * (uid & 1) - 64);
                    else loc::local_unit_nb(QKV, (const bf16*)out, Y, rpbL, (LAS char*)ldsl, seqrow, T, ((uid * 128) - (int)seqrow) >> 6, wave, lane_o);
                }
            }
#endif
        }
        GRID_BAR();
#ifndef NO_P3
        {
            const int gw = vcu * 8 + wave, NGW = G * 8;
            for (int m0 = 4 * gw; m0 < M_TOK; m0 += 12 * NGW) {
                v4u a[3], b[3]; float sc[3];
#pragma unroll
                for (int j = 0; j < 3; ++j) { const int m = min(m0 + j * 4 * NGW + (lanel >> 4), M_TOK - 1); const v4u* p = (const v4u*)(Y + (size_t)m * DM + 16 * (lanel & 15)); a[j] = p[0]; b[j] = p[1]; sc[j] = (float)ssqA[m] * (1.0f / 1073741824.0f); }
#pragma unroll
                for (int j = 0; j < 3; ++j) { const int m = m0 + j * 4 * NGW + (lanel >> 4); if (m >= M_TOK) continue; const float f = rsqrtf(sc[j] * (1.0f / 256.0f) + 1e-6f); v4u* p = (v4u*)(Y + (size_t)m * DM + 16 * (lanel & 15));
#pragma unroll
                    for (int e = 0; e < 4; ++e) { a[j][e] = pk2h(__uint_as_float(a[j][e] << 16) * f, __uint_as_float(a[j][e] & 0xffff0000u) * f); b[j][e] = pk2h(__uint_as_float(b[j][e] << 16) * f, __uint_as_float(b[j][e] & 0xffff0000u) * f); }
                    p[0] = a[j]; p[1] = b[j]; }
            }
        }
        GRID_BAR();
        {
            pg8::Gemm g{Y, Wl + W_OUT, M_TOK, DM, DM}; pg8::StaticOrder S; S.init(M_TOK, DM, G, bx);
            pg8::EpiRes2<false> E{XB, out, ssq_ffn};
            pg8::gemm_phase<pg8::EpiRes2<false>, pg8::StaticOrder, PG_ALIGN, PG_SP2>(ldsl, g, S, E);
        }
#endif
        GRID_BAR();
#ifndef NO_P4
        {
            pg8::Gemm g{XB, Wl + W_GU, M_TOK, 2 * FF, DM}; pg8::StaticOrder S; S.init(M_TOK, 2 * FF, G, bx);
            pg8::EpiGU E{H, ssq_ffn, ldsl + 131072};
            pg8::gemm_phase<pg8::EpiGU, pg8::StaticOrder, PG_ALIGN, PG_SP2>(ldsl, g, S, E);
#ifdef PROBE_P4X2
            __syncthreads();
            pg8::gemm_phase<pg8::EpiGU, pg8::StaticOrder, PG_ALIGN, PG_SP2>(ldsl, g, S, E);
#endif
        }
#endif
        GRID_BAR();
#ifndef NO_P5
        {
            pg8::Gemm g{H, Wl + W_DOWN, M_TOK, DM, FF}; pg8::StaticOrder S; S.init(M_TOK, DM, G, bx);
            if (l + 1 < DEPTH) { pg8::EpiRes2<false> E{XB, out, ssq + (size_t)(l + 1) * M_TOK}; pg8::gemm_phase<pg8::EpiRes2<false>, pg8::StaticOrder, PG_ALIGN, PG_SP2>(ldsl, g, S, E); }
            else { pg8::EpiRes2<true> E{XB, out, nullptr}; pg8::gemm_phase<pg8::EpiRes2<true>, pg8::StaticOrder, PG_ALIGN, PG_SP2>(ldsl, g, S, E); }
        }
#endif
        if (l + 1 < DEPTH) GRID_BAR();
    }
}

extern "C" void kernel_launch(void* const* d_in, const int* in_sizes, int n_in, void* d_out, int out_size, void* d_ws, size_t ws_size, hipStream_t stream) {
    static int grid_blocks = 0;
    if (grid_blocks == 0) {
        if (n_in != 12 || out_size != M_TOK * DM || ws_size < WS_END) { fprintf(stderr, "kernel_launch: unexpected shapes (n_in %d out %d ws %zu)\n", n_in, out_size, ws_size); grid_blocks = -1; return; }
        int dev = 0, cus = 0, per_cu = 0;
        hipGetDevice(&dev); hipDeviceGetAttribute(&cus, hipDeviceAttributeMultiprocessorCount, dev);
        hipFuncSetAttribute((const void*)fwd_megakernel, hipFuncAttributeMaxDynamicSharedMemorySize, LDS_BYTES);
        hipOccupancyMaxActiveBlocksPerMultiprocessor(&per_cu, (const void*)fwd_megakernel, 512, LDS_BYTES);
        if (per_cu < 1) { fprintf(stderr, "kernel_launch: occupancy query says %d blocks per CU\n", per_cu); per_cu = 1; }
        grid_blocks = cus * 1;
    }
    if (grid_blocks < 0) return;
    Args a{};
    for (int i = 0; i < 12; ++i) a.in[i] = (const float*)d_in[i];
    a.out = (float*)d_out; a.ws = (unsigned char*)d_ws;
    void* kargs[] = {&a};
    hipError_t e = hipLaunchCooperativeKernel((const void*)fwd_megakernel, dim3(grid_blocks), dim3(512), kargs, LDS_BYTES, stream);
    if (e != hipSuccess) fprintf(stderr, "cooperative launch failed: %s (grid %d)\n", hipGetErrorString(e), grid_blocks);
}
```
